# Optimizing an MI355X kernel written in HIP

```python
import math
import jax, jax.numpy as jnp
from jax import lax
import numpy as np

D_MODEL = 2048
BATCH = 8
SEQ = 2048
DEPTH = 1

MIX_WIDTH = D_MODEL
ATTN_WIDTH = MIX_WIDTH // 2
DELTA_WIDTH = MIX_WIDTH - ATTN_WIDTH

ATTN_HEAD_DIM = 64
N_ATTN_HEADS = ATTN_WIDTH // ATTN_HEAD_DIM
N_KV_HEADS = N_ATTN_HEADS // 4
GQA_GROUP = N_ATTN_HEADS // N_KV_HEADS
WINDOW = 128
ATTN_BLOCK = 128
NEG_INF = -1e30

N_BUCKETS = 32
MAX_DISTANCE = 128

DELTA_HEAD_DIM = 128
N_DELTA_HEADS = DELTA_WIDTH // DELTA_HEAD_DIM
CONV_WIDTH = 4
CHUNK = 64

D_FF = 4 * D_MODEL

DN_ALPHA = (2.0 * DEPTH) ** 0.25
DN_BETA = (8.0 * DEPTH) ** -0.25
LN_EPS = 1e-5
RMS_EPS = 1e-6

COL_ATTN_Q = N_ATTN_HEADS * ATTN_HEAD_DIM
COL_ATTN_KV = N_KV_HEADS * ATTN_HEAD_DIM
COL_DELTA_QKV = 3 * DELTA_WIDTH
COL_DELTA_SCALAR = N_DELTA_HEADS
COL_DELTA_Z = DELTA_WIDTH
N_IN_COLS = COL_ATTN_Q + 2 * COL_ATTN_KV + COL_DELTA_QKV + 2 * COL_DELTA_SCALAR + COL_DELTA_Z
SPLIT_POINTS = [int(s) for s in np.cumsum([COL_ATTN_Q, COL_ATTN_KV, COL_ATTN_KV, COL_DELTA_QKV,
                                              COL_DELTA_SCALAR, COL_DELTA_SCALAR])]

kernel_name = "hymba_swa_sink_gdn_deepnorm"


def layer_norm(x, g, b):
    xf = x.astype(jnp.float32)
    mu = jnp.mean(xf, axis=-1, keepdims=True)
    xc = xf - mu
    var = jnp.mean(xc * xc, axis=-1, keepdims=True)
    y = xc * lax.rsqrt(var + LN_EPS) * g.astype(jnp.float32) + b.astype(jnp.float32)
    return y.astype(x.dtype)


def t5_causal_bucket(dist):
    n = jnp.maximum(dist, 0)
    max_exact = N_BUCKETS // 2
    nf = jnp.maximum(n, 1).astype(jnp.float32)
    large = max_exact + (jnp.log(nf / max_exact) / math.log(MAX_DISTANCE / max_exact)
                         * (N_BUCKETS - max_exact)).astype(jnp.int32)
    large = jnp.minimum(large, N_BUCKETS - 1)
    return jnp.where(n < max_exact, n, large)


def sliding_window_attention(q, k, v, sinks, rel_bias):
    B, S = q.shape[0], q.shape[1]
    nb = S // ATTN_BLOCK
    qb = q.reshape(B, nb, ATTN_BLOCK, N_KV_HEADS, GQA_GROUP, ATTN_HEAD_DIM)
    kb = k.reshape(B, nb, ATTN_BLOCK, N_KV_HEADS, ATTN_HEAD_DIM)
    vb = v.reshape(B, nb, ATTN_BLOCK, N_KV_HEADS, ATTN_HEAD_DIM)
    pad = ((0, 0), (1, 0), (0, 0), (0, 0), (0, 0))
    kc = jnp.concatenate([jnp.pad(kb, pad)[:, :-1], kb], axis=2)
    vc = jnp.concatenate([jnp.pad(vb, pad)[:, :-1], vb], axis=2)
    logits = jnp.einsum('bnqhgd,bnkhd->bnhgqk', qb, kc).astype(jnp.float32) * (ATTN_HEAD_DIM ** -0.5)
    qi = jnp.arange(ATTN_BLOCK, dtype=jnp.int32)[:, None]
    kj = jnp.arange(2 * ATTN_BLOCK, dtype=jnp.int32)[None, :]
    dist = qi + ATTN_BLOCK - kj
    band = (dist >= 0) & (dist < WINDOW)
    blk = jnp.arange(nb, dtype=jnp.int32)[:, None, None]
    valid = band[None] & ~((blk == 0) & (kj[None] < ATTN_BLOCK))
    bias = rel_bias.astype(jnp.float32)[t5_causal_bucket(dist)]
    bias = bias.transpose(2, 0, 1).reshape(N_KV_HEADS, GQA_GROUP, ATTN_BLOCK, 2 * ATTN_BLOCK)
    logits = jnp.where(valid[None, :, None, None], logits + bias, NEG_INF)
    sink = jnp.broadcast_to(sinks.astype(jnp.float32).reshape(1, 1, N_KV_HEADS, GQA_GROUP, 1, 1),
                            logits.shape[:-1] + (1,))
    probs = jax.nn.softmax(jnp.concatenate([logits, sink], axis=-1), axis=-1)[..., :-1]
    out = jnp.einsum('bnhgqk,bnkhd->bnqhgd', probs.astype(v.dtype), vc)
    return out.reshape(B, S, N_ATTN_HEADS * ATTN_HEAD_DIM)


def chunked_gated_delta_rule(q, k, v, g, beta):
    B, S, H, dk = q.shape
    dv = v.shape[-1]
    nc = S // CHUNK

    def chunkify(t):
        return t.reshape(B, nc, CHUNK, H, -1).transpose(0, 3, 1, 2, 4)

    qc, kc, vc = chunkify(q), chunkify(k), chunkify(v)
    gc = g.reshape(B, nc, CHUNK, H).transpose(0, 3, 1, 2)
    bc = beta.reshape(B, nc, CHUNK, H).transpose(0, 3, 1, 2)
    G = jnp.cumsum(gc, axis=-1)
    tril = jnp.tril(jnp.ones((CHUNK, CHUNK), dtype=bool))
    strict = jnp.tril(jnp.ones((CHUNK, CHUNK), dtype=bool), -1)
    decay_mat = jnp.exp(jnp.where(tril, G[..., :, None] - G[..., None, :], -jnp.inf))
    kbeta = kc * bc[..., None]
    A = jnp.where(strict, jnp.einsum('bhnid,bhnjd->bhnij', kbeta, kc) * decay_mat, 0.0)
    eye = jnp.eye(CHUNK, dtype=jnp.float32)
    rhs = jnp.concatenate([vc * bc[..., None], kbeta * jnp.exp(G)[..., None]], axis=-1)
    sol = lax.linalg.triangular_solve(A + eye, rhs, left_side=True, lower=True, unit_diagonal=True)
    u, w = sol[..., :dv], sol[..., dv:]
    attn_intra = jnp.einsum('bhnid,bhnjd->bhnij', qc, kc) * decay_mat
    q_dec = qc * jnp.exp(G)[..., None]
    k_dec = kc * jnp.exp(G[..., -1:] - G)[..., None]
    g_last = jnp.exp(G[..., -1])

    def step(state, inp):
        q_d, k_d, u_c, w_c, a_c, gl = inp
        v_new = u_c - jnp.einsum('bhcd,bhde->bhce', w_c, state)
        o = jnp.einsum('bhcd,bhde->bhce', q_d, state) + jnp.einsum('bhij,bhje->bhie', a_c, v_new)
        state = state * gl[..., None, None] + jnp.einsum('bhcd,bhce->bhde', k_d, v_new)
        return state, o

    xs = (jnp.moveaxis(q_dec, 2, 0), jnp.moveaxis(k_dec, 2, 0), jnp.moveaxis(u, 2, 0),
          jnp.moveaxis(w, 2, 0), jnp.moveaxis(attn_intra, 2, 0), jnp.moveaxis(g_last, 2, 0))
    s0 = jnp.zeros((B, H, dk, dv), dtype=jnp.float32)
    _, o = lax.scan(step, s0, xs)
    return o.transpose(1, 0, 3, 2, 4).reshape(B, S, H, dv)


def l2_normalise(t):
    return t * lax.rsqrt(jnp.sum(t * t, axis=-1, keepdims=True) + RMS_EPS)


def hybrid_mixer(h, w_in, conv_w, a_log, dt_bias, delta_norm_w, sinks, rel_bias, w_o):
    B, S, _ = h.shape
    proj = h @ w_in
    q_a, k_a, v_a, qkv_d, a_raw, b_raw, z = jnp.split(proj, SPLIT_POINTS, axis=-1)

    attn_out = sliding_window_attention(
        q_a.reshape(B, S, N_ATTN_HEADS, ATTN_HEAD_DIM),
        k_a.reshape(B, S, N_KV_HEADS, ATTN_HEAD_DIM),
        v_a.reshape(B, S, N_KV_HEADS, ATTN_HEAD_DIM), sinks, rel_bias)

    qkv_d = lax.conv_general_dilated(qkv_d, conv_w, window_strides=(1,), padding=[(CONV_WIDTH - 1, 0)],
                                     dimension_numbers=('NWC', 'WIO', 'NWC'),
                                     feature_group_count=COL_DELTA_QKV)
    qkv_d = jax.nn.silu(qkv_d).astype(jnp.float32)
    q_d, k_d, v_d = jnp.split(qkv_d, 3, axis=-1)
    q_d = l2_normalise(q_d.reshape(B, S, N_DELTA_HEADS, DELTA_HEAD_DIM)) * (DELTA_HEAD_DIM ** -0.5)
    k_d = l2_normalise(k_d.reshape(B, S, N_DELTA_HEADS, DELTA_HEAD_DIM))
    v_d = v_d.reshape(B, S, N_DELTA_HEADS, DELTA_HEAD_DIM)
    g = -jnp.exp(a_log.astype(jnp.float32)) * jax.nn.softplus(a_raw.astype(jnp.float32) + dt_bias.astype(jnp.float32))
    beta = jax.nn.sigmoid(b_raw.astype(jnp.float32))
    o_d = chunked_gated_delta_rule(q_d, k_d, v_d, g, beta)
    o_d = o_d * lax.rsqrt(jnp.mean(o_d * o_d, axis=-1, keepdims=True) + RMS_EPS) * delta_norm_w.astype(jnp.float32)
    o_d = o_d * jax.nn.silu(z.astype(jnp.float32)).reshape(B, S, N_DELTA_HEADS, DELTA_HEAD_DIM)
    delta_out = o_d.reshape(B, S, DELTA_WIDTH).astype(h.dtype)

    mix = jnp.concatenate([attn_out, delta_out], axis=-1)
    return mix @ w_o


def squared_relu_mlp(h, w_up, w_down):
    a = jax.nn.relu(h @ w_up)
    return (a * a) @ w_down


def setup_inputs(seed: int = 0) -> dict:
    key = jax.random.key(seed)
    ks = jax.random.split(key, 16)
    f32 = jnp.float32
    x = jax.random.normal(ks[0], (BATCH, SEQ, D_MODEL), f32)
    w_in = jax.random.normal(ks[1], (DEPTH, D_MODEL, N_IN_COLS), f32) * D_MODEL ** -0.5
    conv_w = jax.random.normal(ks[2], (DEPTH, CONV_WIDTH, 1, COL_DELTA_QKV), f32) * CONV_WIDTH ** -0.5
    a_log = jnp.log(jax.random.uniform(ks[3], (DEPTH, N_DELTA_HEADS), f32, 1.0, 16.0))
    dt = jnp.exp(jax.random.uniform(ks[4], (DEPTH, N_DELTA_HEADS), f32, math.log(1e-3), math.log(1e-1)))
    dt_bias = dt + jnp.log(-jnp.expm1(-dt))
    delta_norm_w = 1.0 + 0.02 * jax.random.normal(ks[5], (DEPTH, DELTA_HEAD_DIM), f32)
    attn_sinks = 0.5 * jax.random.normal(ks[6], (DEPTH, N_ATTN_HEADS), f32)
    rel_bias = 0.5 * jax.random.normal(ks[7], (N_BUCKETS, N_ATTN_HEADS), f32)
    w_o = jax.random.normal(ks[8], (DEPTH, MIX_WIDTH, D_MODEL), f32) * (MIX_WIDTH ** -0.5 * DN_BETA)
    ln1_g = 1.0 + 0.02 * jax.random.normal(ks[9], (DEPTH, D_MODEL), f32)
    ln1_b = 0.02 * jax.random.normal(ks[10], (DEPTH, D_MODEL), f32)
    w_up = jax.random.normal(ks[11], (DEPTH, D_MODEL, D_FF), f32) * D_MODEL ** -0.5
    w_down = jax.random.normal(ks[12], (DEPTH, D_FF, D_MODEL), f32) * (D_FF ** -0.5 * DN_BETA)
    ln2_g = 1.0 + 0.02 * jax.random.normal(ks[13], (DEPTH, D_MODEL), f32)
    ln2_b = 0.02 * jax.random.normal(ks[14], (DEPTH, D_MODEL), f32)
    return {"x": x, "w_in": w_in, "conv_w": conv_w, "a_log": a_log, "dt_bias": dt_bias,
            "delta_norm_w": delta_norm_w, "attn_sinks": attn_sinks, "rel_bias": rel_bias,
            "w_o": w_o, "ln1_g": ln1_g, "ln1_b": ln1_b, "w_up": w_up, "w_down": w_down,
            "ln2_g": ln2_g, "ln2_b": ln2_b}


def reference(x, w_in, conv_w, a_log, dt_bias, delta_norm_w, attn_sinks, rel_bias,
              w_o, ln1_g, ln1_b, w_up, w_down, ln2_g, ln2_b):
    for l in range(DEPTH):
        mixed = hybrid_mixer(x, w_in[l], conv_w[l], a_log[l], dt_bias[l], delta_norm_w[l],
                             attn_sinks[l], rel_bias, w_o[l])
        x = layer_norm(DN_ALPHA * x + mixed, ln1_g[l], ln1_b[l])
        x = layer_norm(DN_ALPHA * x + squared_relu_mlp(x, w_up[l], w_down[l]), ln2_g[l], ln2_b[l])
    return x
```

```cpp
#include <hip/hip_runtime.h>
#include <cstdio>
#include <cstdint>
namespace pg8 {
#define PG8_LAS __attribute__((address_space(3)))
typedef unsigned short bf16_t;
typedef short bf16x8 __attribute__((ext_vector_type(8)));
typedef float f32x4 __attribute__((ext_vector_type(4)));
typedef unsigned u32x4 __attribute__((ext_vector_type(4)));
constexpr int BM = 256, BK = 64, HALF = 128, HTB = HALF * BK * 2  , STAGE_BYTES = 8 * HTB, NXCD = 8, WGM = 8;

__host__ __device__ __forceinline__ int lds_byte(int r, int c) { const int st = (r >> 4) * 2 + (c >> 5), rr = r & 15, cc = c & 31, ob = rr * 64 + cc * 2; return st * 1024 + (ob ^ (((ob >> 9) & 1) << 5)); }
__host__ __device__ __forceinline__ void stage_rc(int b, int& R, int& C) { const int st = b / 1024, sb = b % 1024, swz = sb ^ (((sb >> 9) & 1) << 5); R = (st >> 1) * 16 + swz / 64; C = (st & 1) * 32 + (swz % 64) / 2; }
__host__ __device__ __forceinline__ int perm32(int rho) { const int n = rho >> 4, i = rho & 15; return 8 * (i >> 2) + 4 * n + (i & 3); }

struct Unit { int pm, pn; };
struct Gemm { const bf16_t* A; const bf16_t* Bt; int M, N, K; };

struct StaticOrder {
    int nM, nN, nwg, G, c;
    __host__ __device__ void init(int M, int N, int G_, int c_) { nM = M / BM; nN = N / BM; nwg = nM * nN; G = G_; c = c_; }
    __host__ __device__ bool next(int i, Unit& u) const {
        const long L = (long)i * G + c; if (L >= nwg) return false;
        int wgid = (int)L; { const int q = nwg / NXCD, r = nwg % NXCD, xcd = wgid % NXCD, off = wgid / NXCD; wgid = (xcd < r ? xcd * (q + 1) : r * (q + 1) + (xcd - r) * q) + off; }
        const int nig = WGM * nN, gid = wgid / nig, fm = gid * WGM, gsz = (nM - fm) < WGM ? (nM - fm) : WGM;
        u.pm = fm + ((wgid % nig) % gsz); u.pn = (wgid % nig) / gsz; return true;
    }
    __device__ __forceinline__ void a_ready(const Unit&) const {}
    __device__ __forceinline__ void done(const Unit&) const {}
};

__device__ __forceinline__ unsigned cvt_pk_bf16(float lo, float hi) { unsigned r; asm volatile("v_cvt_pk_bf16_f32 %0, %1, %2" : "=v"(r) : "v"(lo), "v"(hi)); return r; }
struct EpiProj {
    static constexpr bool PERM = true, AFTER_DRAIN = false;
    bf16_t* O; int ldc; float* gb; float qscale;
    __device__ __forceinline__ void operator()(const f32x4 (&acc)[2][2][4][2], const Unit& u, int wr, int wc, int fr, int fq) const {
        const int row0 = u.pm * BM + wr * 64 + fr;
        if (u.pn == 22) {
            if (wc == 0 && fq < 2) {
#pragma unroll
                for (int ai = 0; ai < 2; ++ai)
#pragma unroll
                    for (int m = 0; m < 4; ++m) { float* p = gb + (size_t)(row0 + ai * HALF + m * 16) * 16 + 8 * fq;
                        *(f32x4*)p = acc[ai][0][m][0]; *(f32x4*)(p + 4) = acc[ai][0][m][1]; }
            }
            return;
        }
        const float sc = (u.pn < 4) ? qscale : 1.f;
        const int col0 = u.pn * BM + wc * 32 + 8 * fq;
#pragma unroll
        for (int ai = 0; ai < 2; ++ai)
#pragma unroll
            for (int m = 0; m < 4; ++m) { bf16_t* rowp = O + (size_t)(row0 + ai * HALF + m * 16) * ldc + col0;
#pragma unroll
                for (int bj = 0; bj < 2; ++bj) { const f32x4 v0 = acc[ai][bj][m][0] * sc, v1 = acc[ai][bj][m][1] * sc;
                    u32x4 w; w.x = cvt_pk_bf16(v0[0], v0[1]); w.y = cvt_pk_bf16(v0[2], v0[3]); w.z = cvt_pk_bf16(v1[0], v1[1]); w.w = cvt_pk_bf16(v1[2], v1[3]);
                    *(u32x4*)(rowp + bj * HALF) = w; } }
    }
};
__device__ __forceinline__ float xrow16_sum(float x) {
    auto s = __builtin_amdgcn_permlane16_swap(__float_as_uint(x), __float_as_uint(x), false, false);
    x = __uint_as_float(s[0]) + __uint_as_float(s[1]);
    auto t = __builtin_amdgcn_permlane32_swap(__float_as_uint(x), __float_as_uint(x), false, false);
    return __uint_as_float(t[0]) + __uint_as_float(t[1]);
}
__device__ __forceinline__ float __attribute__((ext_vector_type(2))) rowstat8(const float* st8, int row) {
    typedef float f32x2v __attribute__((ext_vector_type(2)));
    const f32x4* p = (const f32x4*)(st8 + (size_t)row * 16); const f32x4 a = p[0], b = p[1], c = p[2], d = p[3];
    const float s = ((a[0] + a[2]) + (b[0] + b[2])) + ((c[0] + c[2]) + (d[0] + d[2])), q = ((a[1] + a[3]) + (b[1] + b[3])) + ((c[1] + c[3]) + (d[1] + d[3]));
    const float mean = s * (1.f / 2048.f), var = fmaxf(q * (1.f / 2048.f) - mean * mean, 0.f);
    return (f32x2v){mean, __builtin_amdgcn_rsqf(var + 1e-5f)};
}
struct EpiY1 {
    static constexpr bool PERM = false, AFTER_DRAIN = false;
    const bf16_t* base; bf16_t* yb; float* st8; int ldc; float alpha; PG8_LAS float* pl;
    __device__ __forceinline__ void operator()(const f32x4 (&acc)[2][2][4][2], const Unit& u, int wr, int wc, int fr, int fq) const {
        typedef float f32x2v __attribute__((ext_vector_type(2))); typedef unsigned u32x2v __attribute__((ext_vector_type(2)));
        const int row0 = u.pm * BM + wr * 64 + fr, col0 = u.pn * BM + wc * 32 + 4 * fq;
#pragma unroll
        for (int ai = 0; ai < 2; ++ai) {
        u32x2v b[4][2][2];
#pragma unroll
            for (int m = 0; m < 4; ++m) { const size_t off = (size_t)(row0 + ai * HALF + m * 16) * ldc + col0;
#pragma unroll
                for (int bj = 0; bj < 2; ++bj)
#pragma unroll
                    for (int n = 0; n < 2; ++n) b[m][bj][n] = *(const u32x2v*)(base + off + bj * HALF + n * 16); }
#pragma unroll
            for (int m = 0; m < 4; ++m) { const int row = row0 + ai * HALF + m * 16; const size_t off = (size_t)row * ldc + col0;
                float s = 0.f, q = 0.f;
#pragma unroll
                for (int bj = 0; bj < 2; ++bj)
#pragma unroll
                    for (int n = 0; n < 2; ++n) { const u32x2v xv = b[m][bj][n];
                        const f32x4 xf = {__uint_as_float(xv.x << 16), __uint_as_float(xv.x & 0xffff0000u), __uint_as_float(xv.y << 16), __uint_as_float(xv.y & 0xffff0000u)};
                        const f32x4 y = acc[ai][bj][m][n] + xf * alpha;
                        u32x2v w; w.x = cvt_pk_bf16(y[0], y[1]); w.y = cvt_pk_bf16(y[2], y[3]); *(u32x2v*)(yb + off + bj * HALF + n * 16) = w;
                        s += (y[0] + y[1]) + (y[2] + y[3]); q += (y[0] * y[0] + y[1] * y[1]) + (y[2] * y[2] + y[3] * y[3]); }
                s = xrow16_sum(s); q = xrow16_sum(q);
                if (fq == 0) *(PG8_LAS f32x2v*)(pl + ((ai * HALF + wr * 64 + m * 16 + fr) * 4 + wc) * 2) = (f32x2v){s, q}; }
            asm volatile("" ::: "memory"); }
        asm volatile("s_waitcnt lgkmcnt(0)" ::: "memory"); __builtin_amdgcn_s_barrier(); asm volatile("" ::: "memory");
        { const int t = threadIdx.x; if (t < 256) { const f32x4 a = *(const PG8_LAS f32x4*)(pl + t * 8), b = *(const PG8_LAS f32x4*)(pl + t * 8 + 4);
              *(f32x2v*)(st8 + ((size_t)(u.pm * BM + t) * 8 + u.pn) * 2) = (f32x2v){(a[0] + a[2]) + (b[0] + b[2]), (a[1] + a[3]) + (b[1] + b[3])}; } }
    }
};
struct EpiUp {
    static constexpr bool PERM = true, AFTER_DRAIN = false;
    bf16_t* O; int ldc; const float* st8; const float* cv; const float* dv; int pm0;
    __device__ __forceinline__ void operator()(const f32x4 (&acc)[2][2][4][2], const Unit& u, int wr, int wc, int fr, int fq) const {
        typedef float f32x2v __attribute__((ext_vector_type(2)));
        const int row0 = u.pm * BM + wr * 64 + fr, col0 = u.pn * BM + wc * 32 + 8 * fq;
        extern __shared__ __attribute__((aligned(16))) unsigned char pg8_dynlds[];
        const PG8_LAS float* tbl = (const PG8_LAS float*)((PG8_LAS unsigned char*)pg8_dynlds + 131072 + 8192);
        f32x4 c0[2][2], d0[2][2];
#pragma unroll
        for (int bj = 0; bj < 2; ++bj)
#pragma unroll
            for (int n = 0; n < 2; ++n) { c0[bj][n] = *(const f32x4*)(cv + col0 + bj * HALF + 4 * n); d0[bj][n] = *(const f32x4*)(dv + col0 + bj * HALF + 4 * n); }
#pragma unroll
        for (int ai = 0; ai < 2; ++ai)
#pragma unroll
            for (int m = 0; m < 4; ++m) { const int row = row0 + ai * HALF + m * 16; bf16_t* rowp = O + (size_t)row * ldc + col0;
                const f32x2v rs = (u.pm == pm0) ? *(const PG8_LAS f32x2v*)(tbl + (ai * HALF + wr * 64 + m * 16 + fr) * 2) : rowstat8(st8, row);
#pragma unroll
                for (int bj = 0; bj < 2; ++bj) { f32x4 v0 = (acc[ai][bj][m][0] - c0[bj][0] * rs.x) * rs.y + d0[bj][0], v1 = (acc[ai][bj][m][1] - c0[bj][1] * rs.x) * rs.y + d0[bj][1];
#pragma unroll
                    for (int i = 0; i < 4; ++i) { const float a = fmaxf(v0[i], 0.f), b = fmaxf(v1[i], 0.f); v0[i] = a * a; v1[i] = b * b; }
                    u32x4 w; w.x = cvt_pk_bf16(v0[0], v0[1]); w.y = cvt_pk_bf16(v0[2], v0[3]); w.z = cvt_pk_bf16(v1[0], v1[1]); w.w = cvt_pk_bf16(v1[2], v1[3]);
                    *(u32x4*)(rowp + bj * HALF) = w; } }
    }
};
struct EpiDown {
    static constexpr bool PERM = false, AFTER_DRAIN = false;
    bf16_t* io; int ldc; const float* st8; const float* g; const float* bb; float alpha; int pm0;
    __device__ __forceinline__ void operator()(const f32x4 (&acc)[2][2][4][2], const Unit& u, int wr, int wc, int fr, int fq) const {
        typedef float f32x2v __attribute__((ext_vector_type(2))); typedef unsigned u32x2v __attribute__((ext_vector_type(2)));
        const int row0 = u.pm * BM + wr * 64 + fr, col0 = u.pn * BM + wc * 32 + 4 * fq;
        extern __shared__ __attribute__((aligned(16))) unsigned char pg8_dynlds[];
        const PG8_LAS float* tbl = (const PG8_LAS float*)((PG8_LAS unsigned char*)pg8_dynlds + 131072 + 8192);
        f32x4 gv[2][2], bv[2][2];
#pragma unroll
        for (int bj = 0; bj < 2; ++bj)
#pragma unroll
            for (int n = 0; n < 2; ++n) { gv[bj][n] = *(const f32x4*)(g + col0 + bj * HALF + n * 16) * alpha; bv[bj][n] = *(const f32x4*)(bb + col0 + bj * HALF + n * 16) * alpha; }
#pragma unroll
        for (int ai = 0; ai < 2; ++ai) {
        u32x2v yv[4][2][2]; f32x2v rsv[4];
#pragma unroll
            for (int m = 0; m < 4; ++m) { const int row = row0 + ai * HALF + m * 16; const size_t off = (size_t)row * ldc + col0;
                rsv[m] = (u.pm == pm0) ? *(const PG8_LAS f32x2v*)(tbl + (ai * HALF + wr * 64 + m * 16 + fr) * 2) : rowstat8(st8, row);
#pragma unroll
                for (int bj = 0; bj < 2; ++bj)
#pragma unroll
                    for (int n = 0; n < 2; ++n) yv[m][bj][n] = *(const u32x2v*)(io + off + bj * HALF + n * 16); }
#pragma unroll
            for (int m = 0; m < 4; ++m) { const int row = row0 + ai * HALF + m * 16; const size_t off = (size_t)row * ldc + col0;
                const f32x2v rs = rsv[m];
#pragma unroll
                for (int bj = 0; bj < 2; ++bj)
#pragma unroll
                    for (int n = 0; n < 2; ++n) { const u32x2v v = yv[m][bj][n];
                        const f32x4 y = {__uint_as_float(v.x << 16), __uint_as_float(v.x & 0xffff0000u), __uint_as_float(v.y << 16), __uint_as_float(v.y & 0xffff0000u)};
                        const f32x4 o = acc[ai][bj][m][n] + ((y - rs.x) * rs.y) * gv[bj][n] + bv[bj][n];
                        u32x2v w; w.x = cvt_pk_bf16(o[0], o[1]); w.y = cvt_pk_bf16(o[2], o[3]); *(u32x2v*)(io + off + bj * HALF + n * 16) = w; } }
            asm volatile("" ::: "memory"); }
    }
};

template <class Epi, class Sched, bool ALIGN_EPI = false, bool SP2 = false>
__device__ __forceinline__ void gemm_phase(PG8_LAS unsigned char* lds, const Gemm g, const Sched& S, const Epi& E) {
    const int tid = threadIdx.x, wid = __builtin_amdgcn_readfirstlane(tid >> 6), lane = tid & 63, wr = wid >> 2, wc = wid & 3, fr = lane & 15, fq = lane >> 4;
    const int K = g.K, nt = K / BK;
    unsigned voffA[2], voffB[2];
#pragma unroll
    for (int i = 0; i < 2; ++i) { int R, C; stage_rc(tid * 16 + i * 8192, R, C); const int Rb = Epi::PERM ? ((R & ~31) + perm32(R & 31)) : R;
        voffA[i] = (unsigned)(R * K + C) * 2u; voffB[i] = (unsigned)(Rb * K + C) * 2u; }
    const size_t kstep = (size_t)(BK * 2);
    const size_t hstep = (size_t)HALF * K * 2;
    const size_t tstep = 2 * hstep;
    const unsigned ldsw = (unsigned)wid * 1024u;
    const int aoff = lds_byte(wr * 64 + fr, fq * 8), boff = lds_byte(wc * 32 + fr, fq * 8);
#define PG8_SA(b, h) (((b) * 2 + (h)) * HTB)
#define PG8_SB(b, h) ((4 + (b) * 2 + (h)) * HTB)
#define PG8_STAGE(bufoff, gbase, voff) do { _Pragma("unroll") for (int _i = 0; _i < 2; ++_i) \
        __builtin_amdgcn_global_load_lds((const unsigned*)((const char*)(gbase) + (voff)[_i]), (PG8_LAS unsigned*)(lds + (bufoff) + ldsw + _i * 8192), 16, 0, 0); } while (0)
#define PG8_LDA(dst, b, h) do { _Pragma("unroll") for (int m = 0; m < 4; ++m) _Pragma("unroll") for (int k = 0; k < 2; ++k) dst[m][k] = *(const PG8_LAS bf16x8*)(lds + PG8_SA(b, h) + aoff + m * 2048 + k * 1024); } while (0)
#define PG8_LDB(dst, b, h) do { _Pragma("unroll") for (int n = 0; n < 2; ++n) _Pragma("unroll") for (int k = 0; k < 2; ++k) dst[n][k] = *(const PG8_LAS bf16x8*)(lds + PG8_SB(b, h) + boff + n * 2048 + k * 1024); } while (0)
#define PG8_MMA(ai, bj, At, Bt) do { __builtin_amdgcn_s_setprio(1); _Pragma("unroll") for (int m = 0; m < 4; ++m) _Pragma("unroll") for (int n = 0; n < 2; ++n) _Pragma("unroll") for (int k = 0; k < 2; ++k) \
        acc[ai][bj][m][n] = __builtin_amdgcn_mfma_f32_16x16x32_bf16(Bt[n][k], At[m][k], acc[ai][bj][m][n], 0, 0, 0); __builtin_amdgcn_s_setprio(0); } while (0)
#define PG8_WAIT_V(n) asm volatile("s_waitcnt vmcnt(" #n ")" ::: "memory")
#define PG8_WAIT_L(n) asm volatile("s_waitcnt lgkmcnt(" #n ")" ::: "memory")
#define PG8_BAR __builtin_amdgcn_s_barrier()
#define PG8_SCHED __builtin_amdgcn_sched_barrier(0)
    Unit cur, nxt; int ui = 0;
    if (!S.next(0, cur)) return;
    f32x4 acc[2][2][4][2];
#pragma unroll
    for (int a = 0; a < 2; ++a)
#pragma unroll
        for (int b = 0; b < 2; ++b)
#pragma unroll
            for (int m = 0; m < 4; ++m)
#pragma unroll
                for (int n = 0; n < 2; ++n) acc[a][b][m][n] = (f32x4){0.f, 0.f, 0.f, 0.f};
    bf16x8 At[4][2], B0[2][2], B1[2][2];
    const char* cA = (const char*)g.A + (size_t)cur.pm * tstep; const char* cB = (const char*)g.Bt + (size_t)cur.pn * tstep;
    S.a_ready(cur);
    if constexpr (SP2) {
        PG8_STAGE(PG8_SB(0, 0), cB, voffB); PG8_STAGE(PG8_SB(0, 1), cB + hstep, voffB); PG8_STAGE(PG8_SA(0, 0), cA, voffA); PG8_STAGE(PG8_SA(0, 1), cA + hstep, voffA);
        if (wr == 1) PG8_BAR;
        PG8_WAIT_V(2); PG8_BAR;
        PG8_STAGE(PG8_SB(1, 0), cB + kstep, voffB); PG8_STAGE(PG8_SA(1, 0), cA + kstep, voffA); PG8_STAGE(PG8_SB(1, 1), cB + hstep + kstep, voffB);
        PG8_WAIT_V(6); PG8_BAR;
    } else {
        PG8_STAGE(PG8_SB(0, 0), cB, voffB); PG8_STAGE(PG8_SA(0, 0), cA, voffA); PG8_STAGE(PG8_SB(0, 1), cB + hstep, voffB); PG8_STAGE(PG8_SA(0, 1), cA + hstep, voffA);
        if (wr == 1) PG8_BAR;
        PG8_WAIT_V(4); PG8_BAR;
        PG8_STAGE(PG8_SB(1, 0), cB + kstep, voffB); PG8_STAGE(PG8_SA(1, 0), cA + kstep, voffA); PG8_STAGE(PG8_SB(1, 1), cB + hstep + kstep, voffB);
        PG8_WAIT_V(6); PG8_BAR;
    }
    for (;;) {
        const bool has_next = S.next(ui + 1, nxt);
        const char* nA = has_next ? (const char*)g.A + (size_t)nxt.pm * tstep : cA; const char* nB = has_next ? (const char*)g.Bt + (size_t)nxt.pn * tstep : cB;
        for (int t = 0; t < nt; t += 2) {
            const bool last = (t == nt - 2);
            const char* a1 = cA + (size_t)(t + 1) * kstep;
            const char* a2 = last ? nA : cA + (size_t)(t + 2) * kstep; const char* b2 = last ? nB : cB + (size_t)(t + 2) * kstep;
            const char* a3 = a2 + kstep; const char* b3 = b2 + kstep;
            if (last && has_next) S.a_ready(nxt);
            if constexpr (SP2) {
            PG8_LDB(B0, 0, 0); PG8_LDB(B1, 0, 1); PG8_SCHED; PG8_LDA(At, 0, 0); PG8_STAGE(PG8_SA(1, 1), a1 + hstep, voffA);
            PG8_WAIT_V(8); PG8_WAIT_L(0); PG8_BAR; PG8_MMA(0, 0, At, B0); PG8_MMA(0, 1, At, B1); PG8_BAR; PG8_SCHED;
            PG8_LDA(At, 0, 1); PG8_STAGE(PG8_SB(0, 0), b2, voffB); PG8_STAGE(PG8_SB(0, 1), b2 + hstep, voffB); PG8_STAGE(PG8_SA(0, 0), a2, voffA);
            PG8_WAIT_V(8); PG8_WAIT_L(0); PG8_BAR; PG8_MMA(1, 0, At, B0); PG8_MMA(1, 1, At, B1); PG8_BAR; PG8_SCHED;
            PG8_LDB(B0, 1, 0); PG8_LDB(B1, 1, 1); PG8_SCHED; PG8_LDA(At, 1, 0); PG8_STAGE(PG8_SA(0, 1), a2 + hstep, voffA);
            PG8_WAIT_V(8); PG8_WAIT_L(0); PG8_BAR; PG8_MMA(0, 0, At, B0); PG8_MMA(0, 1, At, B1); PG8_BAR; PG8_SCHED;
            PG8_LDA(At, 1, 1); PG8_STAGE(PG8_SB(1, 0), b3, voffB); PG8_STAGE(PG8_SB(1, 1), b3 + hstep, voffB); PG8_STAGE(PG8_SA(1, 0), a3, voffA);
            PG8_WAIT_V(8); PG8_WAIT_L(0); PG8_BAR; PG8_MMA(1, 0, At, B0); PG8_MMA(1, 1, At, B1); PG8_BAR; PG8_SCHED;
            } else {
            PG8_LDB(B0, 0, 0); PG8_SCHED; PG8_LDA(At, 0, 0); PG8_STAGE(PG8_SA(1, 1), a1 + hstep, voffA);
            PG8_WAIT_L(8); PG8_BAR; PG8_WAIT_L(0); PG8_MMA(0, 0, At, B0); PG8_BAR; PG8_SCHED;
            PG8_LDB(B1, 0, 1); PG8_STAGE(PG8_SB(0, 0), b2, voffB);
            PG8_BAR; PG8_WAIT_L(0); PG8_MMA(0, 1, At, B1); PG8_BAR;
            PG8_LDA(At, 0, 1); PG8_STAGE(PG8_SA(0, 0), a2, voffA);
            PG8_BAR; PG8_WAIT_L(0); PG8_MMA(1, 0, At, B0); PG8_BAR; PG8_SCHED;
            PG8_STAGE(PG8_SB(0, 1), b2 + hstep, voffB);
            PG8_WAIT_V(6); PG8_BAR; PG8_MMA(1, 1, At, B1); PG8_BAR;
            PG8_LDB(B0, 1, 0); PG8_SCHED; PG8_LDA(At, 1, 0); PG8_STAGE(PG8_SA(0, 1), a2 + hstep, voffA);
            PG8_WAIT_L(8); PG8_BAR; PG8_WAIT_L(0); PG8_MMA(0, 0, At, B0); PG8_BAR; PG8_SCHED;
            PG8_LDB(B1, 1, 1); PG8_STAGE(PG8_SB(1, 0), b3, voffB);
            PG8_BAR; PG8_WAIT_L(0); PG8_MMA(0, 1, At, B1); PG8_BAR;
            PG8_LDA(At, 1, 1); PG8_STAGE(PG8_SA(1, 0), a3, voffA);
            PG8_BAR; PG8_WAIT_L(0); PG8_MMA(1, 0, At, B0); PG8_BAR; PG8_SCHED;
            PG8_STAGE(PG8_SB(1, 1), b3 + hstep, voffB);
            PG8_WAIT_V(6); PG8_BAR; PG8_MMA(1, 1, At, B1); PG8_BAR;
            }
        }
        if constexpr (ALIGN_EPI) { if (wr == 0) PG8_BAR; }
        if constexpr (!Epi::AFTER_DRAIN) { E(acc, cur, wr, wc, fr, fq); S.done(cur); }
        if (!has_next) break;
#pragma unroll
        for (int a = 0; a < 2; ++a)
#pragma unroll
            for (int b = 0; b < 2; ++b)
#pragma unroll
                for (int m = 0; m < 4; ++m)
#pragma unroll
                    for (int n = 0; n < 2; ++n) acc[a][b][m][n] = (f32x4){0.f, 0.f, 0.f, 0.f};
        cur = nxt; cA = nA; cB = nB; ++ui;
        if constexpr (ALIGN_EPI) { if (wr == 1) PG8_BAR; }
    }
    PG8_WAIT_V(0);
    if constexpr (!ALIGN_EPI) { if (wr == 0) PG8_BAR; }
    PG8_BAR;
    if constexpr (Epi::AFTER_DRAIN) { E.fused(acc, cur, wr, wc, fr, fq, lds, wid, lane); S.done(cur); }
#undef PG8_SA
#undef PG8_SB
#undef PG8_STAGE
#undef PG8_LDA
#undef PG8_LDB
#undef PG8_MMA
#undef PG8_WAIT_V
#undef PG8_WAIT_L
#undef PG8_BAR
#undef PG8_SCHED
}
}

constexpr int NWAVES = 8;
#ifndef MK_N_LAUNCHES
#define MK_N_LAUNCHES 1
#endif
constexpr int PER_PHASE = 10;
constexpr int N_LAUNCHES = MK_N_LAUNCHES;
constexpr int NB = 8, SEQ = 2048, D = 2048, M = NB * SEQ, FF = 8192;
constexpr int NIN = 5648, NPROJ = 5888, LDP = 5632;
constexpr int COL_QA = 0, COL_KA = 1024, COL_VA = 1280, COL_QD = 1536, COL_KD = 2560, COL_VD = 3584, COL_Z = 4608;
constexpr float LOG2E = 1.4426950408889634f;
constexpr float QSCALE = 0.125f * LOG2E;
constexpr float DN_ALPHA = 1.189207115002721f;
constexpr float LN_EPS = 1e-5f, RMS_EPS = 1e-6f;

constexpr size_t MiB = 1u << 20;
constexpr size_t WS_CTL = 0, CTL_ZERO_BYTES = 65536;
constexpr size_t WS_WIN = 1 * MiB, WS_WO = 24 * MiB, WS_WUP = 32 * MiB, WS_WDN = 64 * MiB;
constexpr size_t WS_X1B = 96 * MiB;
constexpr size_t WS_GB = 160 * MiB, WS_GG = 161 * MiB, WS_BB = WS_GG + 512 * 1024, WS_BIAS = 162 * MiB;
constexpr size_t WS_PC = 163 * MiB, WS_PD = 164 * MiB, WS_CV = 165 * MiB, WS_ST32 = 166 * MiB, WS_RS = 170 * MiB;
constexpr size_t WS_XB = 192 * MiB, WS_MIX = 448 * MiB;
constexpr size_t WS_PROJ = 256 * MiB;
constexpr size_t WS_OBUF = 448 * MiB;
constexpr size_t WS_H = 192 * MiB;
constexpr size_t WS_END = 512 * MiB;
static_assert(WS_WIN + (size_t)NPROJ * D * 2 <= WS_WO && WS_PROJ + (size_t)M * LDP * 2 <= WS_OBUF && WS_H + (size_t)M * FF * 2 <= WS_END, "d_ws map");
constexpr int CW_BAR = 4096;
constexpr int LATE_END = (FF / 32) * (D / 64) + (D / 32) * (FF / 64) + (D / 32) * (D / 64), LATE_SPLIT = 4096;

constexpr int RING_OFF = 0, RING_BYTES = 162816;
constexpr int LDSCTL_OFF = RING_BYTES, MISC_OFF = LDSCTL_OFF + 320;
constexpr int LDS_BYTES = 163840;

#define GAS __attribute__((address_space(1)))
#define LAS __attribute__((address_space(3)))
typedef unsigned short bf16;
typedef unsigned v4u __attribute__((ext_vector_type(4)));
typedef unsigned v2u __attribute__((ext_vector_type(2)));
typedef float f32x4 __attribute__((ext_vector_type(4)));
typedef float f32x2 __attribute__((ext_vector_type(2)));
typedef GAS unsigned gu32;
#define RLX_AGENT __ATOMIC_RELAXED, __HIP_MEMORY_SCOPE_AGENT
#define LDS_WAIT() asm volatile("s_waitcnt lgkmcnt(0)" ::: "memory")
#define VM_WAIT() asm volatile("s_waitcnt vmcnt(0)" ::: "memory")
__device__ __forceinline__ unsigned f2bf(float f) { unsigned u = __builtin_bit_cast(unsigned, f); return (u + 0x7fffu + ((u >> 16) & 1u)) >> 16; }
__device__ __forceinline__ unsigned pk2(float lo, float hi) { return f2bf(lo) | (f2bf(hi) << 16); }
__device__ __forceinline__ float bflo(unsigned raw) { return __uint_as_float(raw << 16); }
__device__ __forceinline__ float bfhi(unsigned raw) { return __uint_as_float(raw & 0xffff0000u); }
__device__ __forceinline__ float wave_sum(float v) {
#pragma unroll
    for (int o = 1; o < 64; o <<= 1) v += __shfl_xor(v, o);
    return v;
}
__device__ __forceinline__ float silu_f(float v) { return v / (1.f + __expf(-v)); }

#define XB_TMO      128
#define XB_XCNT(j)  (256  + 64 * (j))
#define XB_XSUB(j)  (1280 + 64 * (j))
#define XB_XGEN(j)  (2304 + 64 * (j))
#define XB_TOP      3328
#define XB_TOPGEN   3392
#define XCD_BAR_WORDS 3456
#define XB_SPIN_CAP (1u << 18)

__device__ __forceinline__ unsigned xb_ld(unsigned* p)              { return __hip_atomic_load(p, __ATOMIC_RELAXED, __HIP_MEMORY_SCOPE_AGENT); }
__device__ __forceinline__ unsigned xb_add(unsigned* p, unsigned v) { return __hip_atomic_fetch_add(p, v, __ATOMIC_RELAXED, __HIP_MEMORY_SCOPE_AGENT); }
__device__ __forceinline__ unsigned xb_xcc_id() { return (unsigned)__builtin_amdgcn_s_getreg((3 << 11) | 20) & 0xFu; }
#define XB_SPIN(cond, bar) do { unsigned _sp = 0; while (cond) { __builtin_amdgcn_s_sleep(1); \
    if ((++_sp & 255u) == 0u) { if (xb_ld(&(bar)[XB_TMO])) break; if (_sp > XB_SPIN_CAP) { atomicAdd(&(bar)[XB_TMO], 1u); break; } } } } while (0)

struct XcdBarrier {
    unsigned* bar; unsigned x;
    volatile LAS unsigned* st;
};

__device__ __forceinline__ XcdBarrier xcd_barrier_post(unsigned* bar, volatile LAS unsigned* st) {
    XcdBarrier b; b.bar = bar; b.x = xb_xcc_id(); b.st = st;
    if (threadIdx.x == 0) (void)xb_add(&bar[XB_XCNT(b.x)], 1u);
    return b;
}
__device__ __forceinline__ void xcd_barrier_complete(unsigned* bar, unsigned x, unsigned& nloc, unsigned& nx) {
    const unsigned G = gridDim.x * gridDim.y * gridDim.z;
    unsigned sum, cnt, mine, sp = 0u;
    for (;;) {
        sum = 0u; cnt = 0u; mine = 0u;
#pragma unroll
        for (unsigned j = 0; j < 16; ++j) { const unsigned c = xb_ld(&bar[XB_XCNT(j)]); sum += c; cnt += (c > 0u) ? 1u : 0u; mine = (j == x) ? c : mine; }
        if (sum == G) break;
        __builtin_amdgcn_s_sleep(1);
        if ((++sp & 255u) == 0u) { if (xb_ld(&bar[XB_TMO])) break; if (sp > XB_SPIN_CAP) { atomicAdd(&bar[XB_TMO], 1u); break; } }
    }
    nloc = mine > 0u ? mine : 1u; nx = cnt > 0u ? cnt : 1u;
}

__device__ __forceinline__ void xcd_barrier(const XcdBarrier& b) {
    asm volatile("s_waitcnt vmcnt(0)" ::: "memory");
    __syncthreads();
    if (threadIdx.x == 0) {
        unsigned* bar = b.bar;
        __builtin_amdgcn_s_waitcnt(0);
        unsigned nloc = b.st[0], nx = b.st[1];
        if (nloc == 0u) { xcd_barrier_complete(bar, b.x, nloc, nx); b.st[0] = nloc; b.st[1] = nx; }
        const unsigned old = xb_add(&bar[XB_XSUB(b.x)], 1u);
        const unsigned gen = old / nloc;
        if (old + 1u == (gen + 1u) * nloc) {
            __builtin_amdgcn_fence(__ATOMIC_RELEASE, "agent");
            asm volatile("s_waitcnt vmcnt(0)" ::: "memory");
            const unsigned og = xb_add(&bar[XB_TOP], 1u);
            const unsigned tg = og / nx;
            if (og + 1u == (tg + 1u) * nx) xb_add(&bar[XB_TOPGEN], 1u);
            else XB_SPIN(xb_ld(&bar[XB_TOPGEN]) == tg, bar);
            __builtin_amdgcn_fence(__ATOMIC_ACQUIRE, "agent");
            xb_add(&bar[XB_XGEN(b.x)], 1u);
            asm volatile("s_waitcnt vmcnt(0)" ::: "memory");
        } else {
            XB_SPIN(xb_ld(&bar[XB_XGEN(b.x)]) == gen, bar);
            __builtin_amdgcn_fence(__ATOMIC_ACQUIRE, "agent");
            asm volatile("s_waitcnt vmcnt(0)" ::: "memory");
        }
    }
    __syncthreads();
}

struct Frame {
    LAS unsigned char* lds;
    volatile LAS unsigned* MISC;
    gu32* ctl;
    int tid, lane, wave, vcu, G;
    const float *x, *w_in, *conv_w, *a_log, *dt_bias, *norm_w, *sinks, *rel_bias, *w_o, *ln1_g, *ln1_b, *w_up, *w_down, *ln2_g, *ln2_b;
    float* out;
    bf16 *Win_t, *Wo_t, *Wup_t, *Wdn_t, *xb, *mix, *proj, *x1b, *hb;
    float *gbuf, *gg, *bb, *biasd, *biasT, *obuf, *glast;
    unsigned char *FR, *UU;
    float *pc, *pd, *cv, *dv, *st32, *rowstat;
    bf16* gz;
};

__device__ __forceinline__ void p0_item(const float* W, int K, int N, bf16* WT, int dst_row0, int src_col0, int nvalid, int k0, LAS float* scr, int lane) {
    { const int r_ = lane >> 3, c4 = (lane & 7) * 4;
      f32x4 v[8];
#pragma unroll
      for (int i = 0; i < 8; ++i) v[i] = (c4 < nvalid) ? __builtin_nontemporal_load((const GAS f32x4*)(W + (size_t)(k0 + 8 * i + r_) * N + src_col0 + c4)) : (f32x4){0.f, 0.f, 0.f, 0.f};
#pragma unroll
      for (int i = 0; i < 8; ++i) { LAS float* d = scr + (8 * i + r_) * 33 + c4; d[0] = v[i].x; d[1] = v[i].y; d[2] = v[i].z; d[3] = v[i].w; } }
    LDS_WAIT(); asm volatile("" ::: "memory");
    const int c = lane & 7;
#pragma unroll
    for (int j = 0; j < 4; ++j) { const int n = (lane >> 3) + 8 * j; const LAS float* s = scr + (8 * c) * 33 + n;
        v4u o; o.x = pk2(s[0 * 33], s[1 * 33]); o.y = pk2(s[2 * 33], s[3 * 33]); o.z = pk2(s[4 * 33], s[5 * 33]); o.w = pk2(s[6 * 33], s[7 * 33]);
        *(GAS v4u*)(WT + (size_t)(dst_row0 + n) * K + k0 + 8 * c) = o; }
    LDS_WAIT(); asm volatile("" ::: "memory");
}
__device__ __forceinline__ void p0_item_up(const float* W, const float* g, const float* b, bf16* WT, float* pc, float* pd, int nb, int kb, LAS float* scr, int lane) {
    const int n_ = lane & 31, n0 = 32 * nb, k0 = 64 * kb;
    { const int r_ = lane >> 3, c4 = (lane & 7) * 4;
      f32x4 v[8];
#pragma unroll
      for (int i = 0; i < 8; ++i) v[i] = __builtin_nontemporal_load((const GAS f32x4*)(W + (size_t)(k0 + 8 * i + r_) * FF + n0 + c4));
#pragma unroll
      for (int i = 0; i < 8; ++i) { LAS float* d = scr + (8 * i + r_) * 33 + c4; d[0] = v[i].x; d[1] = v[i].y; d[2] = v[i].z; d[3] = v[i].w; } }
    LDS_WAIT(); asm volatile("" ::: "memory");
    const int c = lane & 7;
    float gk[8];
#pragma unroll
    for (int e = 0; e < 8; ++e) gk[e] = g[k0 + 8 * c + e];
#pragma unroll
    for (int j = 0; j < 4; ++j) { const int n = (lane >> 3) + 8 * j; const LAS float* s = scr + (8 * c) * 33 + n;
        v4u o; o.x = pk2(s[0 * 33] * gk[0], s[1 * 33] * gk[1]); o.y = pk2(s[2 * 33] * gk[2], s[3 * 33] * gk[3]); o.z = pk2(s[4 * 33] * gk[4], s[5 * 33] * gk[5]); o.w = pk2(s[6 * 33] * gk[6], s[7 * 33] * gk[7]);
        *(GAS v4u*)(WT + (size_t)(n0 + n) * D + k0 + 8 * c) = o; }
    { const int half = lane >> 5; float cs = 0.f, ds = 0.f;
#pragma unroll 8
      for (int i = 0; i < 32; ++i) { const int kk = 32 * half + i; const float w = scr[kk * 33 + n_]; cs += __uint_as_float(f2bf(w * g[k0 + kk]) << 16); ds += w * b[k0 + kk]; }
      cs += __shfl_xor(cs, 32); ds += __shfl_xor(ds, 32);
      if (half == 0) { pc[(size_t)kb * FF + n0 + n_] = cs; pd[(size_t)kb * FF + n0 + n_] = ds; } }
    LDS_WAIT(); asm volatile("" ::: "memory");
}
__device__ __forceinline__ void p0_prologue(Frame& F) {
    LAS float* scr = (LAS float*)(F.lds + RING_OFF + F.wave * 16384);
    const int gw = F.vcu * NWAVES + F.wave, NGW = F.G * NWAVES, lane = F.lane;
    constexpr int NB_IN = NPROJ / 32, I_IN = NB_IN * (D / 64), I_O = (D / 32) * (D / 64), I_UP = (FF / 32) * (D / 64), I_DN = (D / 32) * (FF / 64);
    constexpr int NITEMS = I_IN + I_O + I_UP + I_DN;
    const int nitems = (F.G == 256) ? I_IN : NITEMS;
    for (int it = gw; it < nitems; it += NGW) {
        int r = it;
        if (r < I_IN) { const int nb = r % NB_IN, kb = r / NB_IN, n0 = 32 * nb; int src, nv;
            if (n0 < 4608) { src = n0; nv = 32; } else if (n0 < 5632) { src = n0 + 16; nv = 32; } else if (n0 == 5632) { src = 4608; nv = 16; } else { src = 0; nv = 0; }
            p0_item(F.w_in, D, NIN, F.Win_t, n0, src, nv, 64 * kb, scr, lane); continue; }
        r -= I_IN;
        if (r < I_O) { const int nb = r % (D / 32), kb = r / (D / 32); p0_item(F.w_o, D, D, F.Wo_t, 32 * nb, 32 * nb, 32, 64 * kb, scr, lane); continue; }
        r -= I_O;
        if (r < I_UP) { const int nb = r % (FF / 32), kb = r / (FF / 32); p0_item_up(F.w_up, F.ln1_g, F.ln1_b, F.Wup_t, F.pc, F.pd, nb, kb, scr, lane); continue; }
        r -= I_UP;
        { const int nb = r % (D / 32), kb = r / (D / 32); p0_item(F.w_down, FF, D, F.Wdn_t, 32 * nb, 32 * nb, 32, 64 * kb, scr, lane); }
    }
    for (size_t base = (size_t)gw * 1024; base < (size_t)M * D; base += (size_t)NGW * 1024) {
        f32x4 v[4];
#pragma unroll
        for (int j = 0; j < 4; ++j) v[j] = __builtin_nontemporal_load((const GAS f32x4*)(F.x + base + j * 256 + lane * 4));
#pragma unroll
        for (int j = 0; j < 4; ++j) { v2u o; o.x = pk2(v[j].x, v[j].y); o.y = pk2(v[j].z, v[j].w); *(GAS v2u*)(F.xb + base + j * 256 + lane * 4) = o; }
    }
    if (blockIdx.x == 0) {
        for (int i = F.tid; i < 2048; i += NWAVES * 64) { const int dist = i >> 4, head = i & 15; int bk;
            if (dist < 16) bk = dist; else { bk = 16 + (int)(logf((float)dist / 16.0f) / 2.0794415416798357f * 16.0f); bk = bk < 31 ? bk : 31; }
            F.biasd[i] = F.rel_bias[bk * 16 + head] * LOG2E; F.biasT[head * 128 + dist] = F.rel_bias[bk * 16 + head] * LOG2E; }
    }
}

__device__ __forceinline__ void late_items(Frame& F, int lo, int hi, int w, int nw) {
    LAS float* scr = (LAS float*)(F.lds + RING_OFF + F.wave * 16384);
    constexpr int I_UP = (FF / 32) * (D / 64), I_DN = (D / 32) * (FF / 64);
    for (int it = lo + w; it < hi; it += nw) {
        if (it < I_UP) { const int nb = it % (FF / 32), kb = it / (FF / 32); p0_item_up(F.w_up, F.ln1_g, F.ln1_b, F.Wup_t, F.pc, F.pd, nb, kb, scr, F.lane); }
        else if (it < I_UP + I_DN) { const int r = it - I_UP, nb = r % (D / 32), kb = r / (D / 32); p0_item(F.w_down, FF, D, F.Wdn_t, 32 * nb, 32 * nb, 32, 64 * kb, scr, F.lane); }
        else { const int r = it - I_UP - I_DN, nb = r % (D / 32), kb = r / (D / 32); p0_item(F.w_o, D, D, F.Wo_t, 32 * nb, 32 * nb, 32, 64 * kb, scr, F.lane); }
    }
}

namespace swa {
typedef short bf16x8 __attribute__((ext_vector_type(8)));
typedef short s16x4 __attribute__((ext_vector_type(4)));
typedef float f32x16 __attribute__((ext_vector_type(16)));
typedef unsigned u32x4 __attribute__((ext_vector_type(4)));
typedef __attribute__((address_space(3))) const unsigned char* lcp;
constexpr int L_K = 0, L_V = 32768, L_BIAS = 65536, L_OST = 73728, L_END = L_OST + 8 * 4096;
__device__ __forceinline__ int crow(int r, int hi) { return (r & 3) + 8 * (r >> 2) + 4 * hi; }
__device__ __forceinline__ unsigned cvtpk(float lo, float hi) { typedef float f2 __attribute__((ext_vector_type(2))); typedef __bf16 b2 __attribute__((ext_vector_type(2)));
    f2 v = {lo, hi}; b2 b = __builtin_convertvector(v, b2); return __builtin_bit_cast(unsigned, b); }
__device__ __forceinline__ s16x4 vtr(lcp p) { typedef short v4i16_t __attribute__((ext_vector_type(4)));
    return __builtin_bit_cast(s16x4, __builtin_amdgcn_ds_read_tr16_b64_v4i16((__attribute__((address_space(3))) v4i16_t*)p)); }
__device__ __forceinline__ void qkt(f32x16& p0, f32x16& p1, lcp Kt, const bf16x8* qr, int r32, int hi) {
    lcp kb = Kt + hi * 1024 + r32 * 16;
    f32x16 z;
#pragma unroll
    for (int i = 0; i < 16; ++i) z[i] = 0.f;
    p0 = z; p1 = z;
#pragma unroll
    for (int d0 = 0; d0 < 4; ++d0) {
        const bf16x8 b0 = *(const __attribute__((address_space(3))) bf16x8*)(kb + d0 * 2048);
        const bf16x8 b1 = *(const __attribute__((address_space(3))) bf16x8*)(kb + d0 * 2048 + 512);
        p0 = __builtin_amdgcn_mfma_f32_32x32x16_bf16(b0, qr[d0], p0, 0, 0, 0);
        p1 = __builtin_amdgcn_mfma_f32_32x32x16_bf16(b1, qr[d0], p1, 0, 0, 0);
    }
}
__device__ __forceinline__ void pv(f32x16* o, lcp vp, u32x4 pw0, u32x4 pw1, u32x4 pw2, u32x4 pw3) {
#pragma unroll
    for (int d0 = 0; d0 < 2; ++d0) {
        s16x4 lo[4], hh[4];
#pragma unroll
        for (int ks = 0; ks < 4; ++ks) { lo[ks] = vtr(vp + d0 * 4096 + ks * 1024); hh[ks] = vtr(vp + d0 * 4096 + ks * 1024 + 512); }
#define SWA_PK(k) (bf16x8){lo[k][0], lo[k][1], lo[k][2], lo[k][3], hh[k][0], hh[k][1], hh[k][2], hh[k][3]}
        o[d0] = __builtin_amdgcn_mfma_f32_32x32x16_bf16(__builtin_bit_cast(bf16x8, pw0), SWA_PK(0), o[d0], 0, 0, 0);
        o[d0] = __builtin_amdgcn_mfma_f32_32x32x16_bf16(__builtin_bit_cast(bf16x8, pw1), SWA_PK(1), o[d0], 0, 0, 0);
        o[d0] = __builtin_amdgcn_mfma_f32_32x32x16_bf16(__builtin_bit_cast(bf16x8, pw2), SWA_PK(2), o[d0], 0, 0, 0);
        o[d0] = __builtin_amdgcn_mfma_f32_32x32x16_bf16(__builtin_bit_cast(bf16x8, pw3), SWA_PK(3), o[d0], 0, 0, 0);
#undef SWA_PK
    }
}
__device__ __forceinline__ void maskbias(f32x16& p0, f32x16& p1, int t, int qabs, int hi, const __attribute__((address_space(3))) float* bh) {
    const float NEG = -1e30f;
    float b0[16], b1[16];
#pragma unroll
    for (int r = 0; r < 16; ++r) { const int d0 = qabs - (64 * t + crow(r, hi)), d1 = d0 - 32; b0[r] = bh[min(max(d0, 0), 127)]; b1[r] = bh[min(max(d1, 0), 127)]; }
    asm volatile("" ::: "memory");
#pragma unroll
    for (int r = 0; r < 16; ++r) {
        const int d0 = qabs - (64 * t + crow(r, hi)), d1 = d0 - 32;
        p0[r] = (d0 >= 0 && d0 < 128) ? p0[r] + b0[r] : NEG;
        p1[r] = (d1 >= 0 && d1 < 128) ? p1[r] + b1[r] : NEG;
    }
}
__device__ __forceinline__ float max16(const f32x16& a) {
    float m0 = fmaxf(fmaxf(a[0], a[1]), fmaxf(a[2], a[3])), m1 = fmaxf(fmaxf(a[4], a[5]), fmaxf(a[6], a[7]));
    float m2 = fmaxf(fmaxf(a[8], a[9]), fmaxf(a[10], a[11])), m3 = fmaxf(fmaxf(a[12], a[13]), fmaxf(a[14], a[15]));
    return fmaxf(fmaxf(m0, m1), fmaxf(m2, m3));
}
__device__ __forceinline__ float expsum16(f32x16& a, float m) {
    float s = 0.f;
#pragma unroll
    for (int r = 0; r < 16; ++r) { a[r] = __builtin_amdgcn_exp2f(a[r] - m); s += a[r]; }
    return s;
}
__device__ __forceinline__ void pack_tile(const f32x16& p0, const f32x16& p1, float inv, u32x4& w0, u32x4& w1, u32x4& w2, u32x4& w3) {
    w0 = (u32x4){cvtpk(p0[0] * inv, p0[1] * inv), cvtpk(p0[2] * inv, p0[3] * inv), cvtpk(p0[4] * inv, p0[5] * inv), cvtpk(p0[6] * inv, p0[7] * inv)};
    w1 = (u32x4){cvtpk(p0[8] * inv, p0[9] * inv), cvtpk(p0[10] * inv, p0[11] * inv), cvtpk(p0[12] * inv, p0[13] * inv), cvtpk(p0[14] * inv, p0[15] * inv)};
    w2 = (u32x4){cvtpk(p1[0] * inv, p1[1] * inv), cvtpk(p1[2] * inv, p1[3] * inv), cvtpk(p1[4] * inv, p1[5] * inv), cvtpk(p1[6] * inv, p1[7] * inv)};
    w3 = (u32x4){cvtpk(p1[8] * inv, p1[9] * inv), cvtpk(p1[10] * inv, p1[11] * inv), cvtpk(p1[12] * inv, p1[13] * inv), cvtpk(p1[14] * inv, p1[15] * inv)};
}
}


namespace swa2 {
using namespace swa;
constexpr int L2_BIAS = 131072, L2_OST = 139264;
__device__ __forceinline__ void glds16(const void* gsrc, unsigned lds_dst) { unsigned keep;
    asm volatile("s_mov_b32 %0, m0\n\ts_mov_b32 m0, %2\n\ts_nop 0\n\tglobal_load_lds_dwordx4 %1, off\n\ts_mov_b32 m0, %0" : "=&s"(keep) : "v"(gsrc), "s"(lds_dst) : "memory"); }
struct QSet { u32x4 q0, q1, q2, q3; };
__device__ __forceinline__ void qload(QSet& q, const void* p) {
    asm volatile("global_load_dwordx4 %0, %4, off\n\tglobal_load_dwordx4 %1, %4, off offset:32\n\tglobal_load_dwordx4 %2, %4, off offset:64\n\tglobal_load_dwordx4 %3, %4, off offset:96"
                 : "=&v"(q.q0), "=&v"(q.q1), "=&v"(q.q2), "=&v"(q.q3) : "v"(p) : "memory"); }
template <int N> __device__ __forceinline__ void qwait(QSet& q) { asm volatile("s_waitcnt vmcnt(%4)" : "+v"(q.q0), "+v"(q.q1), "+v"(q.q2), "+v"(q.q3) : "n"(N) : "memory"); }
}

__device__ __forceinline__ void swa_mfma2(Frame& F, int first, int stride) {
    using namespace swa2;
    const int tid = F.tid, lane = F.lane, r32 = lane & 31, hi = lane >> 5, wid = F.wave;
    LAS unsigned char* L = F.lds;
    LAS float* bl = (LAS float*)(L + L2_BIAS);
    for (int i = tid; i < 2048; i += NWAVES * 64) bl[i] = F.biasT[i];
    const unsigned lds0 = (unsigned)(uintptr_t)L;
#define SWA2_DMA(uu, bufoff) do { const int kvh_ = (uu) & 3, blk_ = ((uu) >> 2) & 15, b_ = (uu) >> 6; const size_t rb_ = (size_t)b_ * SEQ; const int tok0_ = blk_ * 128 - 128; \
        _Pragma("unroll") for (int t = 0; t < 4; ++t) { const int ts_ = (blk_ == 0 && t < 2) ? t + 2 : t; \
            const bf16* ksrc_ = F.proj + (rb_ + tok0_ + 64 * ts_ + lane) * LDP + COL_KA + kvh_ * 64 + wid * 8; \
            const bf16* vsrc_ = F.proj + (rb_ + tok0_ + 64 * ts_ + 16 * (wid & 3) + (lane >> 2)) * LDP + COL_VA + kvh_ * 64 + (wid >> 2) * 32 + (lane & 3) * 8; \
            glds16(ksrc_, (unsigned)__builtin_amdgcn_readfirstlane(lds0 + (bufoff) + t * 8192 + wid * 1024)); \
            glds16(vsrc_, (unsigned)__builtin_amdgcn_readfirstlane(lds0 + (bufoff) + 32768 + t * 8192 + wid * 1024)); } } while (0)
#define SWA2_QPTR(uu, qt) (F.proj + ((size_t)((uu) >> 6) * SEQ + (((uu) >> 2) & 15) * 128 + 64 * (wid & 1) + 32 * (qt) + r32) * LDP + COL_QA + (((uu) & 3) * 4 + (wid >> 1)) * 64 + hi * 8)
    if (first >= 512) { LDS_WAIT(); __syncthreads(); return; }
    QSet qa, qb;
    SWA2_DMA(first, 0); qload(qa, SWA2_QPTR(first, 0));
    int it = 0;
    for (int u = first; u < 512; u += stride, ++it) {
        const int kvh = u & 3, blk = (u >> 2) & 15, b = u >> 6;
        const size_t rowbase = (size_t)b * SEQ;
        const int bufoff = (it & 1) * 65536; const bool has_next = (u + stride < 512);
        const int head = kvh * 4 + (wid >> 1);
        const LAS float* bh = bl + head * 128;
        const float sink2 = F.sinks[head] * LOG2E;
        LDS_WAIT(); asm volatile("" ::: "memory"); __builtin_amdgcn_s_barrier(); asm volatile("" ::: "memory");
#pragma unroll
        for (int qt = 0; qt < 2; ++qt) {
            QSet& qc = (qt == 0) ? qa : qb; QSet& qn = (qt == 0) ? qb : qa;
            if (qt == 0) {
                qload(qn, SWA2_QPTR(u, 1));
                if (has_next) { SWA2_DMA(u + stride, 65536 - bufoff); qwait<12>(qc); } else qwait<4>(qc);
                asm volatile("" ::: "memory"); __builtin_amdgcn_s_barrier(); asm volatile("" ::: "memory");
            } else {
                if (has_next) { qload(qn, SWA2_QPTR(u + stride, 0)); qwait<12>(qc); } else qwait<0>(qc);
            }
            const int q0 = 64 * (wid & 1) + 32 * qt, qabs = q0 + r32 + 128;
            bf16x8 qr[4] = {__builtin_bit_cast(bf16x8, qc.q0), __builtin_bit_cast(bf16x8, qc.q1), __builtin_bit_cast(bf16x8, qc.q2), __builtin_bit_cast(bf16x8, qc.q3)};
            const int tlo0 = (q0 < 64) ? 0 : 1, thi = tlo0 + 2, tlo = (blk == 0 && tlo0 < 2) ? 2 : tlo0;
            f32x16 P[3][2];
            float mx = -1e30f;
#pragma unroll
            for (int i = 0; i < 3; ++i) {
                const int t = tlo + i;
                if (t <= thi) { qkt(P[i][0], P[i][1], (lcp)(L + bufoff + t * 8192), qr, r32, hi); maskbias(P[i][0], P[i][1], t, qabs, hi, bh);
                    mx = fmaxf(mx, fmaxf(max16(P[i][0]), max16(P[i][1]))); }
            }
            { auto rr = __builtin_amdgcn_permlane32_swap(__float_as_uint(mx), __float_as_uint(mx), false, false); mx = fmaxf(__uint_as_float(rr[0]), __uint_as_float(rr[1])); }
            mx = fmaxf(mx, sink2);
            float l = 0.f;
#pragma unroll
            for (int i = 0; i < 3; ++i) { if (tlo + i <= thi) { l += expsum16(P[i][0], mx); l += expsum16(P[i][1], mx); } }
            { auto rr = __builtin_amdgcn_permlane32_swap(__float_as_uint(l), __float_as_uint(l), false, false); l = __uint_as_float(rr[0]) + __uint_as_float(rr[1]); }
            l += __builtin_amdgcn_exp2f(sink2 - mx);
            const float inv = __builtin_amdgcn_rcpf(l);
            f32x16 o[2];
#pragma unroll
            for (int i = 0; i < 16; ++i) { o[0][i] = 0.f; o[1][i] = 0.f; }
            lcp vp0 = (lcp)(L + bufoff + 32768) + ((lane >> 4) & 1) * 32 + (lane & 3) * 8 + (4 * hi + ((lane & 15) >> 2)) * 64;
#pragma unroll
            for (int i = 0; i < 3; ++i) {
                const int t = tlo + i;
                if (t <= thi) { u32x4 w0, w1, w2, w3; pack_tile(P[i][0], P[i][1], inv, w0, w1, w2, w3); pv(o, vp0 + t * 8192, w0, w1, w2, w3); }
            }
            LAS unsigned short* stg = (LAS unsigned short*)(L + L2_OST + wid * 2048);
            bf16* Ow = F.mix + (rowbase + blk * 128 + q0) * D + head * 64;
#pragma unroll
            for (int d0 = 0; d0 < 2; ++d0) {
#pragma unroll
                for (int r = 0; r < 16; ++r) stg[crow(r, hi) * 32 + r32] = (unsigned short)f2bf(o[d0][r]);
                LDS_WAIT(); asm volatile("" ::: "memory");
#pragma unroll
                for (int k = 0; k < 2; ++k) { const int id = k * 64 + lane, row = id >> 2, ch = id & 3; const u32x4 v = *(const LAS u32x4*)(stg + row * 32 + ch * 8); *(GAS u32x4*)(Ow + (size_t)row * D + d0 * 32 + ch * 8) = v; }
                LDS_WAIT(); asm volatile("" ::: "memory");
            }
        }
    }
    LDS_WAIT(); __syncthreads();
#undef SWA2_DMA
#undef SWA2_QPTR
}

namespace gdn {
typedef short bf16x8 __attribute__((ext_vector_type(8)));
typedef float f32x16 __attribute__((ext_vector_type(16)));
typedef float f32x4v __attribute__((ext_vector_type(4)));
typedef unsigned u32x4 __attribute__((ext_vector_type(4)));
typedef unsigned u32x2 __attribute__((ext_vector_type(2)));
constexpr int FRB = 54 * 1024, UUB = 16 * 1024;
constexpr int LA = 0, LG = 16384, LQ = 17408, LK = 34816, LV = 52224, LXU = 69632, LXW = 87040, LAT = 104448, LPREP_END = LAT + 64 * 72 * 2;
constexpr int RS = 136;
__device__ __forceinline__ int crow(int r, int hi) { return (r & 3) + 8 * (r >> 2) + 4 * hi; }
__device__ __forceinline__ unsigned cvtpk(float lo, float hi) { typedef float f2 __attribute__((ext_vector_type(2))); typedef __bf16 b2 __attribute__((ext_vector_type(2)));
    f2 v = {lo, hi}; b2 b = __builtin_convertvector(v, b2); return __builtin_bit_cast(unsigned, b); }
__device__ __forceinline__ bf16x8 pack8(const f32x16& x, int s) {
    u32x4 p = {cvtpk(x[8 * s], x[8 * s + 1]), cvtpk(x[8 * s + 2], x[8 * s + 3]), cvtpk(x[8 * s + 4], x[8 * s + 5]), cvtpk(x[8 * s + 6], x[8 * s + 7])};
    return __builtin_bit_cast(bf16x8, p);
}
}


namespace gdn2 {
using namespace gdn;
typedef __attribute__((address_space(3))) const unsigned char* lcp;
typedef short s16x4 __attribute__((ext_vector_type(4)));
constexpr int P2Q = 0, P2K = 17408, P2V = 34816, P2A = 52224, P2T = 69632, P2TU = 87040, P2TW = 96256, P2G = 105472, P2_END = P2G + 4096;
constexpr int AS = 68, TS = 72;
#define LDS_OPAQUE(type, ptr) ({ unsigned a_ = (unsigned)(uintptr_t)(ptr); asm volatile("" : "+v"(a_)); (type)a_; })
__device__ __forceinline__ s16x4 vtr(lcp p) { typedef short v4i16_t __attribute__((ext_vector_type(4)));
    return __builtin_bit_cast(s16x4, __builtin_amdgcn_ds_read_tr16_b64_v4i16((__attribute__((address_space(3))) v4i16_t*)p)); }
template <int CTRL> __device__ __forceinline__ float dppf(float x) { return __builtin_bit_cast(float, __builtin_amdgcn_mov_dpp(__builtin_bit_cast(int, x), CTRL, 0xf, 0xf, true)); }
__device__ __forceinline__ float wsum_dpp(float x) {
    x += dppf<0xB1>(x); x += dppf<0x4E>(x); x += dppf<0x141>(x); x += dppf<0x128>(x);
    auto s = __builtin_amdgcn_permlane16_swap(__float_as_uint(x), __float_as_uint(x), false, false);
    x = __uint_as_float(s[0]) + __uint_as_float(s[1]);
    auto t = __builtin_amdgcn_permlane32_swap(__float_as_uint(x), __float_as_uint(x), false, false);
    return __uint_as_float(t[0]) + __uint_as_float(t[1]);
}
__device__ __forceinline__ void wsum_dpp16(float (&a)[8], float (&b)[8]) {
#pragma unroll
    for (int j = 0; j < 8; ++j) { a[j] += dppf<0xB1>(a[j]); b[j] += dppf<0xB1>(b[j]); }
#pragma unroll
    for (int j = 0; j < 8; ++j) { a[j] += dppf<0x4E>(a[j]); b[j] += dppf<0x4E>(b[j]); }
#pragma unroll
    for (int j = 0; j < 8; ++j) { a[j] += dppf<0x141>(a[j]); b[j] += dppf<0x141>(b[j]); }
#pragma unroll
    for (int j = 0; j < 8; ++j) { a[j] += dppf<0x128>(a[j]); b[j] += dppf<0x128>(b[j]); }
#pragma unroll
    for (int j = 0; j < 8; ++j) { auto s = __builtin_amdgcn_permlane16_swap(__float_as_uint(a[j]), __float_as_uint(a[j]), false, false); a[j] = __uint_as_float(s[0]) + __uint_as_float(s[1]);
                                  auto t = __builtin_amdgcn_permlane16_swap(__float_as_uint(b[j]), __float_as_uint(b[j]), false, false); b[j] = __uint_as_float(t[0]) + __uint_as_float(t[1]); }
#pragma unroll
    for (int j = 0; j < 8; ++j) { auto s = __builtin_amdgcn_permlane32_swap(__float_as_uint(a[j]), __float_as_uint(a[j]), false, false); a[j] = __uint_as_float(s[0]) + __uint_as_float(s[1]);
                                  auto t = __builtin_amdgcn_permlane32_swap(__float_as_uint(b[j]), __float_as_uint(b[j]), false, false); b[j] = __uint_as_float(t[0]) + __uint_as_float(t[1]); }
}
__device__ __forceinline__ bf16x8 cat8(s16x4 a, s16x4 b) { return (bf16x8){a[0], a[1], a[2], a[3], b[0], b[1], b[2], b[3]}; }
template <int B> __device__ __forceinline__ void tchain(const __attribute__((address_space(3))) float* Al, const __attribute__((address_space(3))) float* Tf,
                                                        __attribute__((address_space(3))) unsigned short* Tbu, __attribute__((address_space(3))) unsigned short* Tbw,
                                                        const __attribute__((address_space(3))) float* Gs, int lane) {
    const int i = lane & 15, g = lane >> 4;
    typedef const __attribute__((address_space(3))) float* lfp; typedef __attribute__((address_space(3))) unsigned short* lsp;
    lfp Alp = LDS_OPAQUE(lfp, Al + i * AS + 4 * g), Tfp = LDS_OPAQUE(lfp, Tf + i * AS + 4 * g), Tfb = LDS_OPAQUE(lfp, Tf + 4 * g * AS + i);
    lsp Tup = LDS_OPAQUE(lsp, Tbu + 4 * g * TS + i), Twp = LDS_OPAQUE(lsp, Tbw + 4 * g * TS + i);
    f32x4v Y[4];
    float bd[4];
#pragma unroll
    for (int ks = 0; ks < 4; ++ks) bd[ks] = Tfb[(16 * B + ks) * AS + 16 * B];
    const float cu = Gs[64 + 16 * B + i], cw = Gs[256 + 16 * B + i];
#pragma unroll
    for (int a = B + 1; a < 4; ++a) {
        f32x4v P = {0.f, 0.f, 0.f, 0.f};
        { const f32x4v ao = *(const __attribute__((address_space(3))) f32x4v*)(Alp + (16 * a) * AS + 16 * B);
#pragma unroll
          for (int ks = 0; ks < 4; ++ks) P = __builtin_amdgcn_mfma_f32_16x16x4f32(ao[ks], bd[ks], P, 0, 0, 0); }
#pragma unroll
        for (int m = B + 1; m < a; ++m) { const f32x4v ao = *(const __attribute__((address_space(3))) f32x4v*)(Alp + (16 * a) * AS + 16 * m);
#pragma unroll
            for (int ks = 0; ks < 4; ++ks) P = __builtin_amdgcn_mfma_f32_16x16x4f32(ao[ks], Y[m][ks], P, 0, 0, 0); }
        const f32x4v dop = *(const __attribute__((address_space(3))) f32x4v*)(Tfp + (16 * a) * AS + 16 * a);
        f32x4v y = {0.f, 0.f, 0.f, 0.f};
#pragma unroll
        for (int ks = 0; ks < 4; ++ks) y = __builtin_amdgcn_mfma_f32_16x16x4f32(dop[ks], P[ks], y, 0, 0, 0);
        Y[a] = -y;
#pragma unroll
        for (int r = 0; r < 4; ++r) { Tup[(16 * a + r) * TS + 16 * B] = (unsigned short)f2bf(Y[a][r] * cu); Twp[(16 * a + r) * TS + 16 * B] = (unsigned short)f2bf(Y[a][r] * cw); }
    }
}
}

__device__ __forceinline__ void gdn_prep2(Frame& F) {
    using namespace gdn2;
    const int lane = F.lane, wave = F.wave;
    LAS unsigned char* L = F.lds;
    LAS unsigned short* qb = (LAS unsigned short*)(L + P2Q); LAS unsigned short* kb = (LAS unsigned short*)(L + P2K); LAS unsigned short* vb = (LAS unsigned short*)(L + P2V);
    LAS float* Al = (LAS float*)(L + P2A); LAS float* Tf = (LAS float*)(L + P2T);
    LAS unsigned short* Tbu = (LAS unsigned short*)(L + P2TU); LAS unsigned short* Tbw = (LAS unsigned short*)(L + P2TW);
    LAS float* Gs0 = (LAS float*)(L + P2G);
    const int r32 = lane & 31, hh = lane >> 5;
    for (int e = F.tid; e < 64 * 64; e += NWAVES * 64) { const int row = e >> 6, col = e & 63; if ((col >> 4) > (row >> 4)) { Tbu[row * TS + col] = 0; Tbw[row * TS + col] = 0; } }
    int hcur = -1;
    const f32x2 nwv = *(const GAS f32x2*)(F.norm_w + 2 * lane);
    f32x2 cw[4][3];
#pragma unroll
    for (int w = 0; w < 4; ++w)
#pragma unroll
        for (int p = 0; p < 3; ++p) cw[w][p] = (f32x2){0.f, 0.f};
    unsigned raw[11][3], zraw[8];
#define GDN2_ISSUE_LOADS(chx) do { const int n_ = (chx) & 31, h_ = ((chx) >> 5) & 7, b_ = (chx) >> 8; \
        const bf16* base_ = F.proj + (size_t)(b_ * SEQ + n_ * 64 + 8 * wave) * LDP + COL_QD + h_ * 128 + 2 * lane; \
        _Pragma("unroll") for (int r = 0; r < 11; ++r) { const bool ok_ = (n_ * 64 + 8 * wave - 3 + r) >= 0; \
            _Pragma("unroll") for (int p = 0; p < 3; ++p) raw[r][p] = ok_ ? *(const GAS unsigned*)(base_ + (ptrdiff_t)(r - 3) * LDP + p * 1024) : 0u; } \
        _Pragma("unroll") for (int j = 0; j < 8; ++j) zraw[j] = *(const GAS unsigned*)(base_ + (size_t)j * LDP + (COL_Z - COL_QD)); } while (0)
#define GDN2_GATES(dst, chx, garx, gbrx) do { const int h_ = ((chx) >> 5) & 7; const float ar_ = (garx) + F.dt_bias[h_]; \
        const float sp_ = fmaxf(ar_, 0.f) + log1pf(expf(-fabsf(ar_))); float G_ = -expf(F.a_log[h_]) * sp_; \
        _Pragma("unroll") for (int o = 1; o < 64; o <<= 1) { const float t_ = __shfl_up(G_, o); if (lane >= o) G_ += t_; } \
        const float Gl_ = __shfl(G_, 63), be_ = 1.f / (1.f + expf(-(gbrx))), eg_ = expf(G_); \
        (dst)[lane] = G_; (dst)[64 + lane] = be_; (dst)[128 + lane] = eg_; (dst)[192 + lane] = expf(Gl_ - G_); (dst)[256 + lane] = be_ * eg_; \
        if (lane == 63) F.glast[(chx)] = eg_; } while (0)
#define GDN2_GATE_LOADS(chx) do { const int n_ = (chx) & 31, h_ = ((chx) >> 5) & 7, b_ = (chx) >> 8; const float* gp_ = F.gbuf + (size_t)(b_ * SEQ + n_ * 64 + lane) * 16 + h_; \
        gar = *(const GAS float*)gp_; gbr = *(const GAS float*)(gp_ + 8); } while (0)
    float gar = 0.f, gbr = 0.f;
    if (F.vcu < 2048) { GDN2_ISSUE_LOADS(F.vcu); if (wave == 7) { GDN2_GATE_LOADS(F.vcu); GDN2_GATES(Gs0, F.vcu, gar, gbr); } }
    int itc = 0;
    for (int ch = F.vcu; ch < 2048; ch += F.G) {
        const int n = ch & 31, h = (ch >> 5) & 7, b = ch >> 8;
        LAS float* Gs = Gs0 + (itc & 1) * 512; LAS float* Gn = Gs0 + ((itc & 1) ^ 1) * 512; ++itc;
        if (h != hcur) { hcur = h;
#pragma unroll
            for (int w = 0; w < 4; ++w)
#pragma unroll
                for (int p = 0; p < 3; ++p) cw[w][p] = *(const GAS f32x2*)(F.conv_w + w * 3072 + p * 1024 + h * 128 + 2 * lane); }
        {
            f32x2 xr[11][3];
#pragma unroll
            for (int r = 0; r < 11; ++r)
#pragma unroll
                for (int p = 0; p < 3; ++p) xr[r][p] = (f32x2){bflo(raw[r][p]), bfhi(raw[r][p])};
            f32x2 a[8][3]; float sq[8], sk[8];
#pragma unroll
            for (int j = 0; j < 8; ++j) {
#pragma unroll
                for (int p = 0; p < 3; ++p) {
                    f32x2 c = xr[j][p] * cw[0][p]; c = xr[j + 1][p] * cw[1][p] + c; c = xr[j + 2][p] * cw[2][p] + c; c = xr[j + 3][p] * cw[3][p] + c;
                    const float e0 = __builtin_amdgcn_exp2f(c.x * -LOG2E), e1 = __builtin_amdgcn_exp2f(c.y * -LOG2E);
                    a[j][p] = (f32x2){c.x * __builtin_amdgcn_rcpf(1.f + e0), c.y * __builtin_amdgcn_rcpf(1.f + e1)};
                }
                sq[j] = a[j][0].x * a[j][0].x + a[j][0].y * a[j][0].y; sk[j] = a[j][1].x * a[j][1].x + a[j][1].y * a[j][1].y;
            }
            wsum_dpp16(sq, sk);
#pragma unroll
            for (int j = 0; j < 8; ++j) {
                const float rq = __builtin_amdgcn_rsqf(sq[j] + RMS_EPS) * 0.08838834764831845f, rk = __builtin_amdgcn_rsqf(sk[j] + RMS_EPS);
                const int i = 8 * wave + j;
                *(LAS unsigned*)(qb + i * RS + 2 * lane) = cvtpk(a[j][0].x * rq, a[j][0].y * rq);
                *(LAS unsigned*)(kb + i * RS + 2 * lane) = cvtpk(a[j][1].x * rk, a[j][1].y * rk);
                *(LAS unsigned*)(vb + i * RS + 2 * lane) = cvtpk(a[j][2].x, a[j][2].y);
            }
            bf16* gzp = F.gz + (size_t)(b * SEQ + n * 64 + 8 * wave) * 1024 + h * 128 + 2 * lane;
#pragma unroll
            for (int j = 0; j < 8; ++j) { const float z0 = bflo(zraw[j]), z1 = bfhi(zraw[j]);
                const float s0 = z0 * __builtin_amdgcn_rcpf(1.f + __builtin_amdgcn_exp2f(z0 * -LOG2E)), s1 = z1 * __builtin_amdgcn_rcpf(1.f + __builtin_amdgcn_exp2f(z1 * -LOG2E));
                *(GAS unsigned*)(gzp + (size_t)j * 1024) = cvtpk(s0 * nwv.x, s1 * nwv.y); }
        }
        if (ch + F.G < 2048) { GDN2_ISSUE_LOADS(ch + F.G); if (wave == 7) GDN2_GATE_LOADS(ch + F.G); }
        LDS_WAIT(); asm volatile("" ::: "memory"); __builtin_amdgcn_s_barrier(); asm volatile("" ::: "memory");
        unsigned char* FRc = F.FR + (size_t)ch * FRB;
        if (wave < 3) {
            const int jb = (wave == 2) ? 1 : 0, ib = (wave == 0) ? 0 : 1;
            f32x16 X;
#pragma unroll
            for (int e = 0; e < 16; ++e) X[e] = 0.f;
            const LAS unsigned short* Am = kb + (32 * jb + r32) * RS + 8 * hh; const LAS unsigned short* Bm = qb + (32 * ib + r32) * RS + 8 * hh;
#pragma unroll
            for (int ks = 0; ks < 8; ++ks) X = __builtin_amdgcn_mfma_f32_32x32x16_bf16(*(const LAS bf16x8*)(Am + 16 * ks), *(const LAS bf16x8*)(Bm + 16 * ks), X, 0, 0, 0);
            const int it = 32 * ib + r32; const float Gi = Gs[it];
#pragma unroll
            for (int e = 0; e < 16; ++e) { const int jt = 32 * jb + crow(e, hh); X[e] = (it >= jt) ? X[e] * __builtin_amdgcn_exp2f((Gi - Gs[jt]) * LOG2E) : 0.f; }
            const int f0 = (wave == 0) ? 32 : (wave == 1) ? 34 : 36;
            *(GAS bf16x8*)(FRc + f0 * 1024 + lane * 16) = pack8(X, 0);
            *(GAS bf16x8*)(FRc + (f0 + 1) * 1024 + lane * 16) = pack8(X, 1);
        } else {
            const int fr = lane & 15, fq = lane >> 4;
            for (int jj = wave - 3; jj < 10; jj += 5) {
                const int bi = (jj >= 6) ? 3 : (jj >= 3) ? 2 : (jj >= 1) ? 1 : 0, bj = jj - (bi * (bi + 1)) / 2;
                const LAS unsigned short* Am = kb + (16 * bi + fr) * RS + 8 * fq; const LAS unsigned short* Bm = kb + (16 * bj + fr) * RS + 8 * fq;
                f32x4v acc = {0.f, 0.f, 0.f, 0.f};
#pragma unroll
                for (int ks = 0; ks < 4; ++ks) acc = __builtin_amdgcn_mfma_f32_16x16x32_bf16(*(const LAS bf16x8*)(Am + 32 * ks), *(const LAS bf16x8*)(Bm + 32 * ks), acc, 0, 0, 0);
                const int jt = 16 * bj + fr; const float Gj = Gs[jt];
#pragma unroll
                for (int r = 0; r < 4; ++r) { const int it = 16 * bi + 4 * fq + r; Al[it * AS + jt] = (it > jt) ? acc[r] * Gs[64 + it] * __builtin_amdgcn_exp2f((Gs[it] - Gj) * LOG2E) : 0.f; }
            }
        }
        LDS_WAIT(); asm volatile("" ::: "memory"); __builtin_amdgcn_s_barrier(); asm volatile("" ::: "memory");
        if (wave < 3) {
            const int bb = lane >> 4, c = lane & 15;
            float x[16];
#pragma unroll
            for (int i = 0; i < 16; ++i) x[i] = (i == c) ? 1.f : 0.f;
            const LAS float* Ab = LDS_OPAQUE(const LAS float*, Al + (16 * bb) * AS + 16 * bb);
            LAS float* Tfc = LDS_OPAQUE(LAS float*, Tf + (16 * bb) * AS + 16 * bb + c);
            LAS unsigned short* Tuc = LDS_OPAQUE(LAS unsigned short*, Tbu + (16 * bb) * TS + 16 * bb + c); LAS unsigned short* Twc = LDS_OPAQUE(LAS unsigned short*, Tbw + (16 * bb) * TS + 16 * bb + c);
#pragma unroll
            for (int i = 1; i < 16; ++i) {
                float s = 0.f;
#pragma unroll
                for (int j4 = 0; j4 < (i + 3) / 4; ++j4) { const f32x4v a4 = *(const LAS f32x4v*)(Ab + i * AS + 4 * j4);
#pragma unroll
                    for (int e = 0; e < 4; ++e) if (4 * j4 + e < i) s += a4[e] * x[4 * j4 + e]; }
                x[i] -= s;
            }
#pragma unroll
            for (int i = 0; i < 16; ++i) Tfc[i * AS] = x[i];
            if (wave == 0) { const float cu = Gs[64 + 16 * bb + c], cwv = Gs[256 + 16 * bb + c];
#pragma unroll
                for (int i = 0; i < 16; ++i) { Tuc[i * TS] = (unsigned short)f2bf(x[i] * cu); Twc[i * TS] = (unsigned short)f2bf(x[i] * cwv); } }
            LDS_WAIT(); asm volatile("" ::: "memory");
            if (wave == 0) tchain<0>(Al, Tf, Tbu, Tbw, Gs, lane); else if (wave == 1) tchain<1>(Al, Tf, Tbu, Tbw, Gs, lane); else tchain<2>(Al, Tf, Tbu, Tbw, Gs, lane);
        } else {
            for (int job = wave - 3; job < 32; job += 5) {
                u32x4 o;
                if (job < 16) {
                    const int ib = job >> 3, s = job & 7, row = 32 * ib + r32; const float eg = Gs[128 + row];
                    const u32x2 a = *(const LAS u32x2*)(qb + row * RS + 16 * s + 4 * hh), c = *(const LAS u32x2*)(qb + row * RS + 16 * s + 8 + 4 * hh);
                    o.x = cvtpk(bflo(a.x) * eg, bfhi(a.x) * eg); o.y = cvtpk(bflo(a.y) * eg, bfhi(a.y) * eg); o.z = cvtpk(bflo(c.x) * eg, bfhi(c.x) * eg); o.w = cvtpk(bflo(c.y) * eg, bfhi(c.y) * eg);
                    *(GAS u32x4*)(FRc + (16 + job) * 1024 + lane * 16) = o;
                } else {
                    const int db = (job - 16) >> 2, s = (job - 16) & 3;
                    lcp p = (lcp)kb + ((16 * s + 4 * hh + ((lane & 15) >> 2)) * RS + 32 * db + 16 * ((lane >> 4) & 1) + 4 * (lane & 3)) * 2;
                    const s16x4 lo = vtr(p), hi = vtr(p + 8 * RS * 2);
                    const f32x4v f0 = *(const LAS f32x4v*)(Gs + 192 + 16 * s + 4 * hh), f1 = *(const LAS f32x4v*)(Gs + 192 + 16 * s + 8 + 4 * hh);
                    o.x = cvtpk(__uint_as_float((unsigned)(unsigned short)lo[0] << 16) * f0[0], __uint_as_float((unsigned)(unsigned short)lo[1] << 16) * f0[1]);
                    o.y = cvtpk(__uint_as_float((unsigned)(unsigned short)lo[2] << 16) * f0[2], __uint_as_float((unsigned)(unsigned short)lo[3] << 16) * f0[3]);
                    o.z = cvtpk(__uint_as_float((unsigned)(unsigned short)hi[0] << 16) * f1[0], __uint_as_float((unsigned)(unsigned short)hi[1] << 16) * f1[1]);
                    o.w = cvtpk(__uint_as_float((unsigned)(unsigned short)hi[2] << 16) * f1[2], __uint_as_float((unsigned)(unsigned short)hi[3] << 16) * f1[3]);
                    *(GAS u32x4*)(FRc + (38 + job - 16) * 1024 + lane * 16) = o;
                }
            }
            if (wave == 7 && ch + F.G < 2048) GDN2_GATES(Gn, ch + F.G, gar, gbr);
        }
        LDS_WAIT(); asm volatile("" ::: "memory"); __builtin_amdgcn_s_barrier(); asm volatile("" ::: "memory");
        {
            const int ib = wave & 1, cs = wave >> 1, q = (lane & 15) >> 2;
            const int coff = 32 * cs + 16 * ((lane >> 4) & 1) + 4 * (lane & 3);
            f32x16 au, aw;
#pragma unroll
            for (int e = 0; e < 16; ++e) { au[e] = 0.f; aw[e] = 0.f; }
            const LAS unsigned short* tu = Tbu + (32 * ib + r32) * TS + 8 * hh; const LAS unsigned short* tw = Tbw + (32 * ib + r32) * TS + 8 * hh;
#pragma unroll
            for (int s = 0; s < 4; ++s) {
                if (s < 2 || ib == 1) {
                    lcp pv_ = (lcp)vb + ((16 * s + 8 * hh + q) * RS + coff) * 2; lcp pk_ = (lcp)kb + ((16 * s + 8 * hh + q) * RS + coff) * 2;
                    const bf16x8 vf = cat8(vtr(pv_), vtr(pv_ + 4 * RS * 2)), kf = cat8(vtr(pk_), vtr(pk_ + 4 * RS * 2));
                    au = __builtin_amdgcn_mfma_f32_32x32x16_bf16(*(const LAS bf16x8*)(tu + 16 * s), vf, au, 0, 0, 0);
                    aw = __builtin_amdgcn_mfma_f32_32x32x16_bf16(kf, *(const LAS bf16x8*)(tw + 16 * s), aw, 0, 0, 0);
                }
            }
            unsigned char* Uc = F.UU + (size_t)ch * UUB + ((cs * 2 + ib) * 2) * 1024 + lane * 16;
            *(GAS bf16x8*)(Uc) = pack8(au, 0); *(GAS bf16x8*)(Uc + 1024) = pack8(au, 1);
#pragma unroll
            for (int e = 0; e < 16; ++e) aw[e] = -aw[e];
            *(GAS bf16x8*)(FRc + (ib * 8 + 2 * cs) * 1024 + lane * 16) = pack8(aw, 0);
            *(GAS bf16x8*)(FRc + (ib * 8 + 2 * cs + 1) * 1024 + lane * 16) = pack8(aw, 1);
        }
        LDS_WAIT(); asm volatile("" ::: "memory"); __builtin_amdgcn_s_barrier(); asm volatile("" ::: "memory");
    }
#undef GDN2_ISSUE_LOADS
#undef GDN2_GATES
#undef GDN2_GATE_LOADS
}


__device__ __forceinline__ void gdn_scan2(Frame& F, int first, int stride) {
    using namespace gdn;
    const int lane = F.lane, wave = F.wave;
    LAS unsigned char* L = F.lds;
    constexpr int STG = 2 * FRB, STGB = 64 * RS * 2;
    for (int bh = first; bh < 64; bh += stride) {
        const int ch0 = bh * 32, b = bh >> 3, h = bh & 7;
        LDS_WAIT(); asm volatile("" ::: "memory"); __builtin_amdgcn_s_barrier(); asm volatile("" ::: "memory");
        if (wave >= 4) {
            const int lw = wave - 4;
            { const unsigned char* src = F.FR + (size_t)ch0 * FRB;
              for (int p = lw; p < 54; p += 4) __builtin_amdgcn_global_load_lds((const GAS unsigned*)(src + p * 1024 + lane * 16), (LAS unsigned*)(L + p * 1024), 16, 0, 0); }
            u32x2 zc[8], zn[8];
#pragma unroll
            for (int i = 0; i < 8; ++i) { zc[i] = (u32x2){0u, 0u}; zn[i] = (u32x2){0u, 0u}; }
            const int ehalf = lane >> 5, ecol = (lane & 31) * 4;
            VM_WAIT();
            asm volatile("" ::: "memory"); __builtin_amdgcn_s_barrier(); asm volatile("" ::: "memory");
#pragma unroll 1
            for (int c = 0; c <= 32; ++c) {
                if (c + 1 < 32) {
                    const unsigned char* src = F.FR + (size_t)(ch0 + c + 1) * FRB; LAS unsigned char* dst = L + ((c + 1) & 1) * FRB;
                    for (int p = lw; p < 54; p += 4) __builtin_amdgcn_global_load_lds((const GAS unsigned*)(src + p * 1024 + lane * 16), (LAS unsigned*)(dst + p * 1024), 16, 0, 0);
                }
                if (c < 32) {
                    const bf16* zp = F.gz + (size_t)(b * SEQ + 64 * c + 16 * lw + ehalf) * 1024 + h * 128 + ecol;
#pragma unroll
                    for (int i = 0; i < 8; ++i) zn[i] = *(const GAS u32x2*)(zp + (size_t)(2 * i) * 1024);
                }
                if (c > 0) {
                    const LAS unsigned short* st = (const LAS unsigned short*)(L + STG + ((c - 1) & 1) * STGB) + (16 * lw + ehalf) * RS + ecol;
                    bf16* mp = F.mix + (size_t)(b * SEQ + 64 * (c - 1) + 16 * lw + ehalf) * D + 1024 + h * 128 + ecol;
#pragma unroll
                    for (int i = 0; i < 8; ++i) {
                        const u32x2 ov = *(const LAS u32x2*)(st + (2 * i) * RS);
                        const float o0 = bflo(ov.x), o1 = bfhi(ov.x), o2 = bflo(ov.y), o3 = bfhi(ov.y);
                        float ss = (o0 * o0 + o1 * o1) + (o2 * o2 + o3 * o3);
                        ss += gdn2::dppf<0xB1>(ss); ss += gdn2::dppf<0x4E>(ss); ss += gdn2::dppf<0x141>(ss); ss += gdn2::dppf<0x128>(ss);
                        { auto sw = __builtin_amdgcn_permlane16_swap(__float_as_uint(ss), __float_as_uint(ss), false, false); ss = __uint_as_float(sw[0]) + __uint_as_float(sw[1]); }
                        const float r = __builtin_amdgcn_rsqf(ss * (1.f / 128.f) + RMS_EPS);
                        u32x2 w; w.x = cvtpk(o0 * r * bflo(zc[i].x), o1 * r * bfhi(zc[i].x)); w.y = cvtpk(o2 * r * bflo(zc[i].y), o3 * r * bfhi(zc[i].y));
                        *(GAS u32x2*)(mp + (size_t)(2 * i) * D) = w;
                    }
                }
                VM_WAIT();
#pragma unroll
                for (int i = 0; i < 8; ++i) { asm volatile("" : "+v"(zn[i])); zc[i] = zn[i]; }
                LDS_WAIT();
                asm volatile("" ::: "memory"); __builtin_amdgcn_s_barrier(); asm volatile("" ::: "memory");
            }
        } else {
            asm volatile("" ::: "memory"); __builtin_amdgcn_s_barrier(); asm volatile("" ::: "memory");
            f32x16 S[4]; bf16x8 Sb[4][2];
#pragma unroll
            for (int d = 0; d < 4; ++d) {
#pragma unroll
                for (int i = 0; i < 16; ++i) S[d][i] = 0.f;
                Sb[d][0] = (bf16x8){0, 0, 0, 0, 0, 0, 0, 0}; Sb[d][1] = (bf16x8){0, 0, 0, 0, 0, 0, 0, 0};
            }
            const unsigned char* up0 = F.UU + (size_t)ch0 * UUB + (wave * 4) * 1024 + lane * 16;
            u32x4 uc[4]; float glc = F.glast[ch0];
#pragma unroll
            for (int k = 0; k < 4; ++k) uc[k] = *(const GAS u32x4*)(up0 + k * 1024);
            const int hh = lane >> 5, n32 = lane & 31;
#pragma unroll 1
            for (int c = 0; c <= 32; ++c) {
                if (c < 32) {
                    const LAS unsigned char* buf = L + (c & 1) * FRB + lane * 16;
#define GFRAG(f) (*(const LAS bf16x8*)(buf + (f) * 1024))
                    f32x16 vn[2], o[2];
#pragma unroll
                    for (int ib = 0; ib < 2; ++ib) {
                        const u32x4 u0 = uc[2 * ib], u1 = uc[2 * ib + 1];
                        vn[ib][0] = bflo(u0.x); vn[ib][1] = bfhi(u0.x); vn[ib][2] = bflo(u0.y); vn[ib][3] = bfhi(u0.y); vn[ib][4] = bflo(u0.z); vn[ib][5] = bfhi(u0.z); vn[ib][6] = bflo(u0.w); vn[ib][7] = bfhi(u0.w);
                        vn[ib][8] = bflo(u1.x); vn[ib][9] = bfhi(u1.x); vn[ib][10] = bflo(u1.y); vn[ib][11] = bfhi(u1.y); vn[ib][12] = bflo(u1.z); vn[ib][13] = bfhi(u1.z); vn[ib][14] = bflo(u1.w); vn[ib][15] = bfhi(u1.w);
#pragma unroll
                        for (int i = 0; i < 16; ++i) o[ib][i] = 0.f;
                    }
                    const float gl = glc;
                    if (c + 1 < 32) {
                        const unsigned char* upn = up0 + (size_t)(c + 1) * UUB;
#pragma unroll
                        for (int k = 0; k < 4; ++k) uc[k] = *(const GAS u32x4*)(upn + k * 1024);
                        glc = F.glast[ch0 + c + 1];
                    }
#pragma unroll
                    for (int ib = 0; ib < 2; ++ib)
#pragma unroll
                        for (int s = 0; s < 8; ++s) {
                            vn[ib] = __builtin_amdgcn_mfma_f32_32x32x16_bf16(GFRAG(ib * 8 + s), Sb[s >> 1][s & 1], vn[ib], 0, 0, 0);
                            o[ib] = __builtin_amdgcn_mfma_f32_32x32x16_bf16(GFRAG(16 + ib * 8 + s), Sb[s >> 1][s & 1], o[ib], 0, 0, 0);
                        }
                    bf16x8 Vb[2][2];
#pragma unroll
                    for (int ib = 0; ib < 2; ++ib) { Vb[ib][0] = pack8(vn[ib], 0); Vb[ib][1] = pack8(vn[ib], 1); }
                    o[0] = __builtin_amdgcn_mfma_f32_32x32x16_bf16(GFRAG(32), Vb[0][0], o[0], 0, 0, 0);
                    o[0] = __builtin_amdgcn_mfma_f32_32x32x16_bf16(GFRAG(33), Vb[0][1], o[0], 0, 0, 0);
#pragma unroll
                    for (int s = 0; s < 4; ++s) o[1] = __builtin_amdgcn_mfma_f32_32x32x16_bf16(GFRAG(34 + s), Vb[s >> 1][s & 1], o[1], 0, 0, 0);
#pragma unroll
                    for (int d = 0; d < 4; ++d) {
#pragma unroll
                        for (int i = 0; i < 16; ++i) S[d][i] *= gl;
#pragma unroll
                        for (int s = 0; s < 4; ++s) S[d] = __builtin_amdgcn_mfma_f32_32x32x16_bf16(GFRAG(38 + d * 4 + s), Vb[s >> 1][s & 1], S[d], 0, 0, 0);
                    }
#pragma unroll
                    for (int d = 0; d < 4; ++d) { Sb[d][0] = pack8(S[d], 0); Sb[d][1] = pack8(S[d], 1); }
#undef GFRAG
                    LAS unsigned short* st = (LAS unsigned short*)(L + STG + (c & 1) * STGB) + 32 * wave + n32;
#pragma unroll
                    for (int ib = 0; ib < 2; ++ib)
#pragma unroll
                        for (int r = 0; r < 16; ++r) st[(32 * ib + crow(r, hh)) * RS] = (unsigned short)f2bf(o[ib][r]);
                }
                LDS_WAIT();
                asm volatile("" ::: "memory"); __builtin_amdgcn_s_barrier(); asm volatile("" ::: "memory");
            }
        }
    }
}


__device__ __forceinline__ void ln_rows_bf16(Frame& F, const bf16* y, float* out, const float* g, const float* b) {
    const int gw = F.vcu * NWAVES + F.wave, NGW = F.G * NWAVES, lane = F.lane;
    for (int m = gw; m < M; m += NGW) {
        const GAS v4u* yr = (const GAS v4u*)(y + (size_t)m * D) + lane;
        float v[4][8]; float s = 0.f;
#pragma unroll
        for (int j = 0; j < 4; ++j) { const v4u w = yr[64 * j];
            v[j][0] = bflo(w.x); v[j][1] = bfhi(w.x); v[j][2] = bflo(w.y); v[j][3] = bfhi(w.y); v[j][4] = bflo(w.z); v[j][5] = bfhi(w.z); v[j][6] = bflo(w.w); v[j][7] = bfhi(w.w);
#pragma unroll
            for (int e = 0; e < 8; ++e) s += v[j][e]; }
        const float mean = wave_sum(s) * (1.f / D); float s2 = 0.f;
#pragma unroll
        for (int j = 0; j < 4; ++j)
#pragma unroll
            for (int e = 0; e < 8; ++e) { v[j][e] -= mean; s2 += v[j][e] * v[j][e]; }
        const float rstd = rsqrtf(wave_sum(s2) * (1.f / D) + LN_EPS);
        GAS f32x4* orow = (GAS f32x4*)(out + (size_t)m * D);
#pragma unroll
        for (int j = 0; j < 4; ++j)
#pragma unroll
            for (int hf = 0; hf < 2; ++hf) { const int c4 = 128 * j + 2 * lane + hf;
                const f32x4 gv = *((const GAS f32x4*)g + c4), bv = *((const GAS f32x4*)b + c4);
                f32x4 o; o.x = v[j][4 * hf] * rstd * gv.x + bv.x; o.y = v[j][4 * hf + 1] * rstd * gv.y + bv.y; o.z = v[j][4 * hf + 2] * rstd * gv.z + bv.z; o.w = v[j][4 * hf + 3] * rstd * gv.w + bv.w;
                __builtin_nontemporal_store(o, orow + c4); }
    }
}

struct Args { const float* in[15]; float* out; unsigned char* ws; int ph_lo, ph_hi, li, pad; };
__global__ void __launch_bounds__(NWAVES * 64, 2) mk_fwd(Args args) {
    extern __shared__ __attribute__((aligned(16))) unsigned char lds[];
    Frame F;
    F.lds = (LAS unsigned char*)lds;
    F.MISC = (volatile LAS unsigned*)(F.lds + MISC_OFF);
    F.tid = threadIdx.x; F.lane = F.tid & 63; F.wave = __builtin_amdgcn_readfirstlane(F.tid >> 6);
    F.G = gridDim.x; { const int bx = blockIdx.x; F.vcu = (F.G % 8 == 0) ? (bx % 8) * (F.G / 8) + bx / 8 : bx; }
    unsigned char* ws = args.ws;
    F.ctl = (gu32*)(ws + WS_CTL);
    F.x = args.in[0]; F.w_in = args.in[1]; F.conv_w = args.in[2]; F.a_log = args.in[3]; F.dt_bias = args.in[4]; F.norm_w = args.in[5]; F.sinks = args.in[6]; F.rel_bias = args.in[7];
    F.w_o = args.in[8]; F.ln1_g = args.in[9]; F.ln1_b = args.in[10]; F.w_up = args.in[11]; F.w_down = args.in[12]; F.ln2_g = args.in[13]; F.ln2_b = args.in[14]; F.out = args.out;
    F.Win_t = (bf16*)(ws + WS_WIN); F.Wo_t = (bf16*)(ws + WS_WO); F.Wup_t = (bf16*)(ws + WS_WUP); F.Wdn_t = (bf16*)(ws + WS_WDN);
    F.xb = (bf16*)(ws + WS_XB); F.mix = (bf16*)(ws + WS_MIX); F.proj = (bf16*)(ws + WS_PROJ); F.x1b = (bf16*)(ws + WS_X1B); F.hb = (bf16*)(ws + WS_H);
    F.gbuf = (float*)(ws + WS_GB); F.gg = (float*)(ws + WS_GG); F.bb = (float*)(ws + WS_BB); F.biasd = (float*)(ws + WS_BIAS); F.biasT = (float*)(ws + WS_BIAS + 8192); F.glast = (float*)(ws + WS_BIAS + 16384);
    F.gz = (bf16*)(ws + WS_X1B + 32 * MiB);
    F.FR = (unsigned char*)args.out; F.UU = ws + WS_X1B;
    F.obuf = (float*)(ws + WS_OBUF);
    F.pc = (float*)(ws + WS_PC); F.pd = (float*)(ws + WS_PD); F.cv = (float*)(ws + WS_CV); F.dv = F.cv + FF; F.st32 = (float*)(ws + WS_ST32); F.rowstat = (float*)(ws + WS_RS);
    for (int u = F.tid; u < (LDS_BYTES - LDSCTL_OFF) / 4; u += NWAVES * 64) ((LAS unsigned*)(F.lds + LDSCTL_OFF))[u] = 0u;
    __syncthreads();
    XcdBarrier bar; bar.bar = (unsigned*)(F.ctl + CW_BAR); bar.x = 0; bar.st = nullptr;
    if (N_LAUNCHES != PER_PHASE) bar = xcd_barrier_post((unsigned*)(F.ctl + CW_BAR), F.MISC + 8);
#define GRID_BAR() do { if (N_LAUNCHES != PER_PHASE) xcd_barrier(bar); } while (0)
    const int lo = args.ph_lo, hi = args.ph_hi;
#define IN(k) (lo <= (k) && (k) < hi)
#define BOTH(k) (IN(k) && IN((k) + 1))

    if (IN(0)) { p0_prologue(F); if (BOTH(0)) GRID_BAR(); }
    if (IN(1)) {
        pg8::Gemm g{F.xb, F.Win_t, M, NPROJ, D}; pg8::StaticOrder S; S.init(M, NPROJ, F.G, (int)blockIdx.x);
        pg8::EpiProj E{F.proj, LDP, F.gbuf, QSCALE};
        pg8::gemm_phase<pg8::EpiProj, pg8::StaticOrder, true, true>(F.lds + RING_OFF, g, S, E);
        if (F.G == 256 && blockIdx.x >= 192) late_items(F, 0, LATE_SPLIT, ((int)blockIdx.x - 192) * NWAVES + F.wave, 64 * NWAVES);
        if (BOTH(1)) GRID_BAR();
    }
    if (IN(2)) { gdn_prep2(F); if (BOTH(2)) GRID_BAR(); }
    if (IN(3)) {
        if (F.G > 64) { if (blockIdx.x < 64) gdn_scan2(F, (int)blockIdx.x, 64); else { swa_mfma2(F, (int)blockIdx.x - 64, F.G - 64);
            if (F.G == 256) late_items(F, LATE_SPLIT, LATE_END, ((int)blockIdx.x - 64) * NWAVES + F.wave, 192 * NWAVES); } }
        else { gdn_scan2(F, (int)blockIdx.x, F.G); swa_mfma2(F, (int)blockIdx.x, F.G); }
        if (BOTH(3)) GRID_BAR();
    }
    if (IN(5)) {
        pg8::Gemm g{F.mix, F.Wo_t, M, D, D}; pg8::StaticOrder S; S.init(M, D, F.G, (int)blockIdx.x);
        pg8::EpiY1 E{F.xb, F.x1b, F.st32, D, DN_ALPHA, (LAS float*)(F.lds + 131072)};
        pg8::gemm_phase<pg8::EpiY1, pg8::StaticOrder, true, true>(F.lds + RING_OFF, g, S, E);
        for (int n0 = F.vcu * 32; n0 < FF; n0 += F.G * 32) {
            const int col = F.tid & 31, part = F.tid >> 5;
            float c = F.pc[(size_t)(2 * part) * FF + n0 + col] + F.pc[(size_t)(2 * part + 1) * FF + n0 + col];
            float d = F.pd[(size_t)(2 * part) * FF + n0 + col] + F.pd[(size_t)(2 * part + 1) * FF + n0 + col];
            LAS float* red = (LAS float*)(F.lds + 131072);
            red[part * 32 + col] = c; red[512 + part * 32 + col] = d;
            LDS_WAIT(); __syncthreads();
            if (F.tid < 64) { const LAS float* r = red + (F.tid >> 5) * 512 + (F.tid & 31); float s = 0.f;
#pragma unroll
                for (int p = 0; p < 16; ++p) s += r[p * 32];
                (F.tid < 32 ? F.cv : F.dv)[n0 + (F.tid & 31)] = s; }
            __syncthreads();
        }
        if (BOTH(5)) GRID_BAR();
    }
    if (IN(7)) {
        pg8::Gemm g{F.x1b, F.Wup_t, M, FF, D}; pg8::StaticOrder S; S.init(M, FF, F.G, (int)blockIdx.x);
        LAS float* tbl = (LAS float*)(F.lds + 131072 + 8192); pg8::Unit u0{0, 0}; (void)S.next(0, u0);
        if (F.tid < 256) { const f32x2 rs = pg8::rowstat8(F.st32, u0.pm * 256 + F.tid); tbl[2 * F.tid] = rs.x; tbl[2 * F.tid + 1] = rs.y; }
        LDS_WAIT(); __syncthreads();
        pg8::EpiUp E{F.hb, FF, F.st32, F.cv, F.dv, u0.pm};
        pg8::gemm_phase<pg8::EpiUp, pg8::StaticOrder, true, true>(F.lds + RING_OFF, g, S, E);
        if (BOTH(7)) GRID_BAR();
    }
    if (IN(8)) {
        pg8::Gemm g{F.hb, F.Wdn_t, M, D, FF}; pg8::StaticOrder S; S.init(M, D, F.G, (int)blockIdx.x);
        LAS float* tbl = (LAS float*)(F.lds + 131072 + 8192); pg8::Unit u0{0, 0}; (void)S.next(0, u0);
        if (F.tid < 256) { const f32x2 rs = pg8::rowstat8(F.st32, u0.pm * 256 + F.tid); tbl[2 * F.tid] = rs.x; tbl[2 * F.tid + 1] = rs.y; }
        LDS_WAIT(); __syncthreads();
        pg8::EpiDown E{F.x1b, D, F.st32, F.ln1_g, F.ln1_b, DN_ALPHA, u0.pm};
        pg8::gemm_phase<pg8::EpiDown, pg8::StaticOrder, true, true>(F.lds + RING_OFF, g, S, E);
        if (BOTH(8)) GRID_BAR();
    }
    if (IN(9)) { ln_rows_bf16(F, F.x1b, F.out, F.ln2_g, F.ln2_b); }
#undef IN
#undef BOTH
}

extern "C" void kernel_launch(void* const* d_in, const int* in_sizes, int n_in, void* d_out, int out_size, void* d_ws, size_t ws_size, hipStream_t stream) {
    static int grid = 0;
    if (grid == 0) {
        if (n_in != 15 || in_sizes[0] != M * D || out_size != M * D || ws_size < WS_END) { fprintf(stderr, "kernel_launch: unexpected shapes (n_in %d, in0 %d, out %d, ws %zu); nothing launched\n", n_in, n_in > 0 ? in_sizes[0] : -1, out_size, ws_size); grid = -1; return; }
        int dev = 0, cus = 0;
        if (hipGetDevice(&dev) != hipSuccess || hipDeviceGetAttribute(&cus, hipDeviceAttributeMultiprocessorCount, dev) != hipSuccess) { grid = -1; return; }
        if (hipFuncSetAttribute((const void*)mk_fwd, hipFuncAttributeMaxDynamicSharedMemorySize, LDS_BYTES) != hipSuccess) { fprintf(stderr, "kernel_launch: hipFuncSetAttribute failed\n"); grid = -1; return; }
        int per_cu = 0;
        if (hipOccupancyMaxActiveBlocksPerMultiprocessor(&per_cu, (const void*)mk_fwd, NWAVES * 64, LDS_BYTES) != hipSuccess || per_cu < 1)
            fprintf(stderr, "kernel_launch: note: occupancy query reports %d workgroups per CU\n", per_cu);
        (void)hipGetLastError();
        grid = cus;
    }
    if (grid < 0) return;
    if (hipMemsetAsync((char*)d_ws + WS_CTL, 0, CTL_ZERO_BYTES, stream) != hipSuccess) { fprintf(stderr, "kernel_launch: hipMemsetAsync failed\n"); return; }
    Args a{};
    for (int i = 0; i < 15; ++i) a.in[i] = (const float*)d_in[i];
    a.out = (float*)d_out; a.ws = (unsigned char*)d_ws;
    for (int li = 0; li < N_LAUNCHES; ++li) {
        a.ph_lo = (N_LAUNCHES == PER_PHASE) ? li : 0; a.ph_hi = (N_LAUNCHES == PER_PHASE) ? li + 1 : PER_PHASE; a.li = li;
        hipLaunchKernelGGL(mk_fwd, dim3(grid), dim3(NWAVES * 64), LDS_BYTES, stream, a);
        const hipError_t le = hipPeekAtLastError();
        if (le != hipSuccess) { fprintf(stderr, "kernel_launch: launch %d failed: %s\n", li, hipGetErrorName(le)); break; }
    }
}
```

```cpp
#include <hip/hip_runtime.h>
#include <cstdio>
#include <cstdint>
namespace pg8 {
#define PG8_LAS __attribute__((address_space(3)))
typedef unsigned short bf16_t;
typedef short bf16x8 __attribute__((ext_vector_type(8)));
typedef float f32x4 __attribute__((ext_vector_type(4)));
typedef unsigned u32x4 __attribute__((ext_vector_type(4)));
constexpr int BM = 256, BK = 64, HALF = 128, HTB = HALF * BK * 2  , STAGE_BYTES = 8 * HTB, NXCD = 8, WGM = 8;

__host__ __device__ __forceinline__ int lds_byte(int r, int c) { const int st = (r >> 4) * 2 + (c >> 5), rr = r & 15, cc = c & 31, ob = rr * 64 + cc * 2; return st * 1024 + (ob ^ (((ob >> 9) & 1) << 5)); }
__host__ __device__ __forceinline__ void stage_rc(int b, int& R, int& C) { const int st = b / 1024, sb = b % 1024, swz = sb ^ (((sb >> 9) & 1) << 5); R = (st >> 1) * 16 + swz / 64; C = (st & 1) * 32 + (swz % 64) / 2; }
__host__ __device__ __forceinline__ int perm32(int rho) { const int n = rho >> 4, i = rho & 15; return 8 * (i >> 2) + 4 * n + (i & 3); }

struct Unit { int pm, pn; };
struct Gemm { const bf16_t* A; const bf16_t* Bt; int M, N, K; };

struct StaticOrder {
    int nM, nN, nwg, G, c;
    __host__ __device__ void init(int M, int N, int G_, int c_) { nM = M / BM; nN = N / BM; nwg = nM * nN; G = G_; c = c_; }
    __host__ __device__ bool next(int i, Unit& u) const {
        const long L = (long)i * G + c; if (L >= nwg) return false;
        int wgid = (int)L; { const int q = nwg / NXCD, r = nwg % NXCD, xcd = wgid % NXCD, off = wgid / NXCD; wgid = (xcd < r ? xcd * (q + 1) : r * (q + 1) + (xcd - r) * q) + off; }
        const int nig = WGM * nN, gid = wgid / nig, fm = gid * WGM, gsz = (nM - fm) < WGM ? (nM - fm) : WGM;
        u.pm = fm + ((wgid % nig) % gsz); u.pn = (wgid % nig) / gsz; return true;
    }
    __device__ __forceinline__ void a_ready(const Unit&) const {}
    __device__ __forceinline__ void done(const Unit&) const {}
};

__device__ __forceinline__ unsigned cvt_pk_bf16(float lo, float hi) { unsigned r; asm volatile("v_cvt_pk_bf16_f32 %0, %1, %2" : "=v"(r) : "v"(lo), "v"(hi)); return r; }
struct EpiProj {
    static constexpr bool PERM = true, AFTER_DRAIN = false;
    bf16_t* O; int ldc; float* gb; float qscale;
    __device__ __forceinline__ void operator()(const f32x4 (&acc)[2][2][4][2], const Unit& u, int wr, int wc, int fr, int fq) const {
        const int row0 = u.pm * BM + wr * 64 + fr;
        if (u.pn == 22) {
            if (wc == 0 && fq < 2) {
#pragma unroll
                for (int ai = 0; ai < 2; ++ai)
#pragma unroll
                    for (int m = 0; m < 4; ++m) { float* p = gb + (size_t)(row0 + ai * HALF + m * 16) * 16 + 8 * fq;
                        *(f32x4*)p = acc[ai][0][m][0]; *(f32x4*)(p + 4) = acc[ai][0][m][1]; }
            }
            return;
        }
        const float sc = (u.pn < 4) ? qscale : 1.f;
        const int col0 = u.pn * BM + wc * 32 + 8 * fq;
#pragma unroll
        for (int ai = 0; ai < 2; ++ai)
#pragma unroll
            for (int m = 0; m < 4; ++m) { bf16_t* rowp = O + (size_t)(row0 + ai * HALF + m * 16) * ldc + col0;
#pragma unroll
                for (int bj = 0; bj < 2; ++bj) { const f32x4 v0 = acc[ai][bj][m][0] * sc, v1 = acc[ai][bj][m][1] * sc;
                    u32x4 w; w.x = cvt_pk_bf16(v0[0], v0[1]); w.y = cvt_pk_bf16(v0[2], v0[3]); w.z = cvt_pk_bf16(v1[0], v1[1]); w.w = cvt_pk_bf16(v1[2], v1[3]);
                    *(u32x4*)(rowp + bj * HALF) = w; } }
    }
};
__device__ __forceinline__ float xrow16_sum(float x) {
    auto s = __builtin_amdgcn_permlane16_swap(__float_as_uint(x), __float_as_uint(x), false, false);
    x = __uint_as_float(s[0]) + __uint_as_float(s[1]);
    auto t = __builtin_amdgcn_permlane32_swap(__float_as_uint(x), __float_as_uint(x), false, false);
    return __uint_as_float(t[0]) + __uint_as_float(t[1]);
}
__device__ __forceinline__ float __attribute__((ext_vector_type(2))) rowstat8(const float* st8, int row) {
    typedef float f32x2v __attribute__((ext_vector_type(2)));
    const f32x4* p = (const f32x4*)(st8 + (size_t)row * 16); const f32x4 a = p[0], b = p[1], c = p[2], d = p[3];
    const float s = ((a[0] + a[2]) + (b[0] + b[2])) + ((c[0] + c[2]) + (d[0] + d[2])), q = ((a[1] + a[3]) + (b[1] + b[3])) + ((c[1] + c[3]) + (d[1] + d[3]));
    const float mean = s * (1.f / 2048.f), var = fmaxf(q * (1.f / 2048.f) - mean * mean, 0.f);
    return (f32x2v){mean, __builtin_amdgcn_rsqf(var + 1e-5f)};
}
struct EpiY1 {
    static constexpr bool PERM = false, AFTER_DRAIN = false;
    const bf16_t* base; bf16_t* yb; float* st8; int ldc; float alpha; PG8_LAS float* pl;
    __device__ __forceinline__ void operator()(const f32x4 (&acc)[2][2][4][2], const Unit& u, int wr, int wc, int fr, int fq) const {
        typedef float f32x2v __attribute__((ext_vector_type(2))); typedef unsigned u32x2v __attribute__((ext_vector_type(2)));
        const int row0 = u.pm * BM + wr * 64 + fr, col0 = u.pn * BM + wc * 32 + 4 * fq;
#pragma unroll
        for (int ai = 0; ai < 2; ++ai) {
        u32x2v b[4][2][2];
#pragma unroll
            for (int m = 0; m < 4; ++m) { const size_t off = (size_t)(row0 + ai * HALF + m * 16) * ldc + col0;
#pragma unroll
                for (int bj = 0; bj < 2; ++bj)
#pragma unroll
                    for (int n = 0; n < 2; ++n) b[m][bj][n] = *(const u32x2v*)(base + off + bj * HALF + n * 16); }
#pragma unroll
            for (int m = 0; m < 4; ++m) { const int row = row0 + ai * HALF + m * 16; const size_t off = (size_t)row * ldc + col0;
                float s = 0.f, q = 0.f;
#pragma unroll
                for (int bj = 0; bj < 2; ++bj)
#pragma unroll
                    for (int n = 0; n < 2; ++n) { const u32x2v xv = b[m][bj][n];
                        const f32x4 xf = {__uint_as_float(xv.x << 16), __uint_as_float(xv.x & 0xffff0000u), __uint_as_float(xv.y << 16), __uint_as_float(xv.y & 0xffff0000u)};
                        const f32x4 y = acc[ai][bj][m][n] + xf * alpha;
                        u32x2v w; w.x = cvt_pk_bf16(y[0], y[1]); w.y = cvt_pk_bf16(y[2], y[3]); *(u32x2v*)(yb + off + bj * HALF + n * 16) = w;
                        s += (y[0] + y[1]) + (y[2] + y[3]); q += (y[0] * y[0] + y[1] * y[1]) + (y[2] * y[2] + y[3] * y[3]); }
                s = xrow16_sum(s); q = xrow16_sum(q);
                if (fq == 0) *(PG8_LAS f32x2v*)(pl + ((ai * HALF + wr * 64 + m * 16 + fr) * 4 + wc) * 2) = (f32x2v){s, q}; }
            asm volatile("" ::: "memory"); }
        asm volatile("s_waitcnt lgkmcnt(0)" ::: "memory"); __builtin_amdgcn_s_barrier(); asm volatile("" ::: "memory");
        { const int t = threadIdx.x; if (t < 256) { const f32x4 a = *(const PG8_LAS f32x4*)(pl + t * 8), b = *(const PG8_LAS f32x4*)(pl + t * 8 + 4);
              *(f32x2v*)(st8 + ((size_t)(u.pm * BM + t) * 8 + u.pn) * 2) = (f32x2v){(a[0] + a[2]) + (b[0] + b[2]), (a[1] + a[3]) + (b[1] + b[3])}; } }
    }
};
struct EpiUp {
    static constexpr bool PERM = true, AFTER_DRAIN = false;
    bf16_t* O; int ldc; const float* st8; const float* cv; const float* dv; int pm0;
    __device__ __forceinline__ void operator()(const f32x4 (&acc)[2][2][4][2], const Unit& u, int wr, int wc, int fr, int fq) const {
        typedef float f32x2v __attribute__((ext_vector_type(2)));
        const int row0 = u.pm * BM + wr * 64 + fr, col0 = u.pn * BM + wc * 32 + 8 * fq;
        extern __shared__ __attribute__((aligned(16))) unsigned char pg8_dynlds[];
        const PG8_LAS float* tbl = (const PG8_LAS float*)((PG8_LAS unsigned char*)pg8_dynlds + 131072 + 8192);
        f32x4 c0[2][2], d0[2][2];
#pragma unroll
        for (int bj = 0; bj < 2; ++bj)
#pragma unroll
            for (int n = 0; n < 2; ++n) { c0[bj][n] = *(const f32x4*)(cv + col0 + bj * HALF + 4 * n); d0[bj][n] = *(const f32x4*)(dv + col0 + bj * HALF + 4 * n); }
#pragma unroll
        for (int ai = 0; ai < 2; ++ai)
#pragma unroll
            for (int m = 0; m < 4; ++m) { const int row = row0 + ai * HALF + m * 16; bf16_t* rowp = O + (size_t)row * ldc + col0;
                const f32x2v rs = (u.pm == pm0) ? *(const PG8_LAS f32x2v*)(tbl + (ai * HALF + wr * 64 + m * 16 + fr) * 2) : rowstat8(st8, row);
#pragma unroll
                for (int bj = 0; bj < 2; ++bj) { f32x4 v0 = (acc[ai][bj][m][0] - c0[bj][0] * rs.x) * rs.y + d0[bj][0], v1 = (acc[ai][bj][m][1] - c0[bj][1] * rs.x) * rs.y + d0[bj][1];
#pragma unroll
                    for (int i = 0; i < 4; ++i) { const float a = fmaxf(v0[i], 0.f), b = fmaxf(v1[i], 0.f); v0[i] = a * a; v1[i] = b * b; }
                    u32x4 w; w.x = cvt_pk_bf16(v0[0], v0[1]); w.y = cvt_pk_bf16(v0[2], v0[3]); w.z = cvt_pk_bf16(v1[0], v1[1]); w.w = cvt_pk_bf16(v1[2], v1[3]);
                    *(u32x4*)(rowp + bj * HALF) = w; } }
    }
};
struct EpiDown {
    static constexpr bool PERM = false, AFTER_DRAIN = false;
    bf16_t* io; int ldc; const float* st8; const float* g; const float* bb; float alpha; int pm0;
    __device__ __forceinline__ void operator()(const f32x4 (&acc)[2][2][4][2], const Unit& u, int wr, int wc, int fr, int fq) const {
        typedef float f32x2v __attribute__((ext_vector_type(2))); typedef unsigned u32x2v __attribute__((ext_vector_type(2)));
        const int row0 = u.pm * BM + wr * 64 + fr, col0 = u.pn * BM + wc * 32 + 4 * fq;
        extern __shared__ __attribute__((aligned(16))) unsigned char pg8_dynlds[];
        const PG8_LAS float* tbl = (const PG8_LAS float*)((PG8_LAS unsigned char*)pg8_dynlds + 131072 + 8192);
        f32x4 gv[2][2], bv[2][2];
#pragma unroll
        for (int bj = 0; bj < 2; ++bj)
#pragma unroll
            for (int n = 0; n < 2; ++n) { gv[bj][n] = *(const f32x4*)(g + col0 + bj * HALF + n * 16) * alpha; bv[bj][n] = *(const f32x4*)(bb + col0 + bj * HALF + n * 16) * alpha; }
#pragma unroll
        for (int ai = 0; ai < 2; ++ai) {
        u32x2v yv[4][2][2]; f32x2v rsv[4];
#pragma unroll
            for (int m = 0; m < 4; ++m) { const int row = row0 + ai * HALF + m * 16; const size_t off = (size_t)row * ldc + col0;
                rsv[m] = (u.pm == pm0) ? *(const PG8_LAS f32x2v*)(tbl + (ai * HALF + wr * 64 + m * 16 + fr) * 2) : rowstat8(st8, row);
#pragma unroll
                for (int bj = 0; bj < 2; ++bj)
#pragma unroll
                    for (int n = 0; n < 2; ++n) yv[m][bj][n] = *(const u32x2v*)(io + off + bj * HALF + n * 16); }
#pragma unroll
            for (int m = 0; m < 4; ++m) { const int row = row0 + ai * HALF + m * 16; const size_t off = (size_t)row * ldc + col0;
                const f32x2v rs = rsv[m];
#pragma unroll
                for (int bj = 0; bj < 2; ++bj)
#pragma unroll
                    for (int n = 0; n < 2; ++n) { const u32x2v v = yv[m][bj][n];
                        const f32x4 y = {__uint_as_float(v.x << 16), __uint_as_float(v.x & 0xffff0000u), __uint_as_float(v.y << 16), __uint_as_float(v.y & 0xffff0000u)};
                        const f32x4 o = acc[ai][bj][m][n] + ((y - rs.x) * rs.y) * gv[bj][n] + bv[bj][n];
                        u32x2v w; w.x = cvt_pk_bf16(o[0], o[1]); w.y = cvt_pk_bf16(o[2], o[3]); *(u32x2v*)(io + off + bj * HALF + n * 16) = w; } }
            asm volatile("" ::: "memory"); }
    }
};

template <class Epi, class Sched, bool ALIGN_EPI = false, bool SP2 = false>
__device__ __forceinline__ void gemm_phase(PG8_LAS unsigned char* lds, const Gemm g, const Sched& S, const Epi& E) {
    const int tid = threadIdx.x, wid = __builtin_amdgcn_readfirstlane(tid >> 6), lane = tid & 63, wr = wid >> 2, wc = wid & 3, fr = lane & 15, fq = lane >> 4;
    const int K = g.K, nt = K / BK;
    unsigned voffA[2], voffB[2];
#pragma unroll
    for (int i = 0; i < 2; ++i) { int R, C; stage_rc(tid * 16 + i * 8192, R, C); const int Rb = Epi::PERM ? ((R & ~31) + perm32(R & 31)) : R;
        voffA[i] = (unsigned)(R * K + C) * 2u; voffB[i] = (unsigned)(Rb * K + C) * 2u; }
    const size_t kstep = (size_t)(BK * 2);
    const size_t hstep = (size_t)HALF * K * 2;
    const size_t tstep = 2 * hstep;
    const unsigned ldsw = (unsigned)wid * 1024u;
    const int aoff = lds_byte(wr * 64 + fr, fq * 8), boff = lds_byte(wc * 32 + fr, fq * 8);
#define PG8_SA(b, h) (((b) * 2 + (h)) * HTB)
#define PG8_SB(b, h) ((4 + (b) * 2 + (h)) * HTB)
#define PG8_STAGE(bufoff, gbase, voff) do { _Pragma("unroll") for (int _i = 0; _i < 2; ++_i) \
        __builtin_amdgcn_global_load_lds((const unsigned*)((const char*)(gbase) + (voff)[_i]), (PG8_LAS unsigned*)(lds + (bufoff) + ldsw + _i * 8192), 16, 0, 0); } while (0)
#define PG8_LDA(dst, b, h) do { _Pragma("unroll") for (int m = 0; m < 4; ++m) _Pragma("unroll") for (int k = 0; k < 2; ++k) dst[m][k] = *(const PG8_LAS bf16x8*)(lds + PG8_SA(b, h) + aoff + m * 2048 + k * 1024); } while (0)
#define PG8_LDB(dst, b, h) do { _Pragma("unroll") for (int n = 0; n < 2; ++n) _Pragma("unroll") for (int k = 0; k < 2; ++k) dst[n][k] = *(const PG8_LAS bf16x8*)(lds + PG8_SB(b, h) + boff + n * 2048 + k * 1024); } while (0)
#define PG8_MMA(ai, bj, At, Bt) do { __builtin_amdgcn_s_setprio(1); _Pragma("unroll") for (int m = 0; m < 4; ++m) _Pragma("unroll") for (int n = 0; n < 2; ++n) _Pragma("unroll") for (int k = 0; k < 2; ++k) \
        acc[ai][bj][m][n] = __builtin_amdgcn_mfma_f32_16x16x32_bf16(Bt[n][k], At[m][k], acc[ai][bj][m][n], 0, 0, 0); __builtin_amdgcn_s_setprio(0); } while (0)
#define PG8_WAIT_V(n) asm volatile("s_waitcnt vmcnt(" #n ")" ::: "memory")
#define PG8_WAIT_L(n) asm volatile("s_waitcnt lgkmcnt(" #n ")" ::: "memory")
#define PG8_BAR __builtin_amdgcn_s_barrier()
#define PG8_SCHED __builtin_amdgcn_sched_barrier(0)
    Unit cur, nxt; int ui = 0;
    if (!S.next(0, cur)) return;
    f32x4 acc[2][2][4][2];
#pragma unroll
    for (int a = 0; a < 2; ++a)
#pragma unroll
        for (int b = 0; b < 2; ++b)
#pragma unroll
            for (int m = 0; m < 4; ++m)
#pragma unroll
                for (int n = 0; n < 2; ++n) acc[a][b][m][n] = (f32x4){0.f, 0.f, 0.f, 0.f};
    bf16x8 At[4][2], B0[2][2], B1[2][2];
    const char* cA = (const char*)g.A + (size_t)cur.pm * tstep; const char* cB = (const char*)g.Bt + (size_t)cur.pn * tstep;
    S.a_ready(cur);
    if constexpr (SP2) {
        PG8_STAGE(PG8_SB(0, 0), cB, voffB); PG8_STAGE(PG8_SB(0, 1), cB + hstep, voffB); PG8_STAGE(PG8_SA(0, 0), cA, voffA); PG8_STAGE(PG8_SA(0, 1), cA + hstep, voffA);
        if (wr == 1) PG8_BAR;
        PG8_WAIT_V(2); PG8_BAR;
        PG8_STAGE(PG8_SB(1, 0), cB + kstep, voffB); PG8_STAGE(PG8_SA(1, 0), cA + kstep, voffA); PG8_STAGE(PG8_SB(1, 1), cB + hstep + kstep, voffB);
        PG8_WAIT_V(6); PG8_BAR;
    } else {
        PG8_STAGE(PG8_SB(0, 0), cB, voffB); PG8_STAGE(PG8_SA(0, 0), cA, voffA); PG8_STAGE(PG8_SB(0, 1), cB + hstep, voffB); PG8_STAGE(PG8_SA(0, 1), cA + hstep, voffA);
        if (wr == 1) PG8_BAR;
        PG8_WAIT_V(4); PG8_BAR;
        PG8_STAGE(PG8_SB(1, 0), cB + kstep, voffB); PG8_STAGE(PG8_SA(1, 0), cA + kstep, voffA); PG8_STAGE(PG8_SB(1, 1), cB + hstep + kstep, voffB);
        PG8_WAIT_V(6); PG8_BAR;
    }
    for (;;) {
        const bool has_next = S.next(ui + 1, nxt);
        const char* nA = has_next ? (const char*)g.A + (size_t)nxt.pm * tstep : cA; const char* nB = has_next ? (const char*)g.Bt + (size_t)nxt.pn * tstep : cB;
        for (int t = 0; t < nt; t += 2) {
            const bool last = (t == nt - 2);
            const char* a1 = cA + (size_t)(t + 1) * kstep;
            const char* a2 = last ? nA : cA + (size_t)(t + 2) * kstep; const char* b2 = last ? nB : cB + (size_t)(t + 2) * kstep;
            const char* a3 = a2 + kstep; const char* b3 = b2 + kstep;
            if (last && has_next) S.a_ready(nxt);
            if constexpr (SP2) {
            PG8_LDB(B0, 0, 0); PG8_LDB(B1, 0, 1); PG8_SCHED; PG8_LDA(At, 0, 0); PG8_STAGE(PG8_SA(1, 1), a1 + hstep, voffA);
            PG8_WAIT_V(8); PG8_WAIT_L(0); PG8_BAR; PG8_MMA(0, 0, At, B0); PG8_MMA(0, 1, At, B1); PG8_BAR; PG8_SCHED;
            PG8_LDA(At, 0, 1); PG8_STAGE(PG8_SB(0, 0), b2, voffB); PG8_STAGE(PG8_SB(0, 1), b2 + hstep, voffB); PG8_STAGE(PG8_SA(0, 0), a2, voffA);
            PG8_WAIT_V(8); PG8_WAIT_L(0); PG8_BAR; PG8_MMA(1, 0, At, B0); PG8_MMA(1, 1, At, B1); PG8_BAR; PG8_SCHED;
            PG8_LDB(B0, 1, 0); PG8_LDB(B1, 1, 1); PG8_SCHED; PG8_LDA(At, 1, 0); PG8_STAGE(PG8_SA(0, 1), a2 + hstep, voffA);
            PG8_WAIT_V(8); PG8_WAIT_L(0); PG8_BAR; PG8_MMA(0, 0, At, B0); PG8_MMA(0, 1, At, B1); PG8_BAR; PG8_SCHED;
            PG8_LDA(At, 1, 1); PG8_STAGE(PG8_SB(1, 0), b3, voffB); PG8_STAGE(PG8_SB(1, 1), b3 + hstep, voffB); PG8_STAGE(PG8_SA(1, 0), a3, voffA);
            PG8_WAIT_V(8); PG8_WAIT_L(0); PG8_BAR; PG8_MMA(1, 0, At, B0); PG8_MMA(1, 1, At, B1); PG8_BAR; PG8_SCHED;
            } else {
            PG8_LDB(B0, 0, 0); PG8_SCHED; PG8_LDA(At, 0, 0); PG8_STAGE(PG8_SA(1, 1), a1 + hstep, voffA);
            PG8_WAIT_L(8); PG8_BAR; PG8_WAIT_L(0); PG8_MMA(0, 0, At, B0); PG8_BAR; PG8_SCHED;
            PG8_LDB(B1, 0, 1); PG8_STAGE(PG8_SB(0, 0), b2, voffB);
            PG8_BAR; PG8_WAIT_L(0); PG8_MMA(0, 1, At, B1); PG8_BAR;
            PG8_LDA(At, 0, 1); PG8_STAGE(PG8_SA(0, 0), a2, voffA);
            PG8_BAR; PG8_WAIT_L(0); PG8_MMA(1, 0, At, B0); PG8_BAR; PG8_SCHED;
            PG8_STAGE(PG8_SB(0, 1), b2 + hstep, voffB);
            PG8_WAIT_V(6); PG8_BAR; PG8_MMA(1, 1, At, B1); PG8_BAR;
            PG8_LDB(B0, 1, 0); PG8_SCHED; PG8_LDA(At, 1, 0); PG8_STAGE(PG8_SA(0, 1), a2 + hstep, voffA);
            PG8_WAIT_L(8); PG8_BAR; PG8_WAIT_L(0); PG8_MMA(0, 0, At, B0); PG8_BAR; PG8_SCHED;
            PG8_LDB(B1, 1, 1); PG8_STAGE(PG8_SB(1, 0), b3, voffB);
            PG8_BAR; PG8_WAIT_L(0); PG8_MMA(0, 1, At, B1); PG8_BAR;
            PG8_LDA(At, 1, 1); PG8_STAGE(PG8_SA(1, 0), a3, voffA);
            PG8_BAR; PG8_WAIT_L(0); PG8_MMA(1, 0, At, B0); PG8_BAR; PG8_SCHED;
            PG8_STAGE(PG8_SB(1, 1), b3 + hstep, voffB);
            PG8_WAIT_V(6); PG8_BAR; PG8_MMA(1, 1, At, B1); PG8_BAR;
            }
        }
        if constexpr (ALIGN_EPI) { if (wr == 0) PG8_BAR; }
        if constexpr (!Epi::AFTER_DRAIN) { E(acc, cur, wr, wc, fr, fq); S.done(cur); }
        if (!has_next) break;
#pragma unroll
        for (int a = 0; a < 2; ++a)
#pragma unroll
            for (int b = 0; b < 2; ++b)
#pragma unroll
                for (int m = 0; m < 4; ++m)
#pragma unroll
                    for (int n = 0; n < 2; ++n) acc[a][b][m][n] = (f32x4){0.f, 0.f, 0.f, 0.f};
        cur = nxt; cA = nA; cB = nB; ++ui;
        if constexpr (ALIGN_EPI) { if (wr == 1) PG8_BAR; }
    }
    PG8_WAIT_V(0);
    if constexpr (!ALIGN_EPI) { if (wr == 0) PG8_BAR; }
    PG8_BAR;
    if constexpr (Epi::AFTER_DRAIN) { E.fused(acc, cur, wr, wc, fr, fq, lds, wid, lane); S.done(cur); }
#undef PG8_SA
#undef PG8_SB
#undef PG8_STAGE
#undef PG8_LDA
#undef PG8_LDB
#undef PG8_MMA
#undef PG8_WAIT_V
#undef PG8_WAIT_L
#undef PG8_BAR
#undef PG8_SCHED
}
}

constexpr int NWAVES = 8;
#ifndef MK_N_LAUNCHES
#define MK_N_LAUNCHES 1
#endif
constexpr int PER_PHASE = 10;
constexpr int N_LAUNCHES = MK_N_LAUNCHES;
constexpr int NB = 8, SEQ = 2048, D = 2048, M = NB * SEQ, FF = 8192;
constexpr int NIN = 5648, NPROJ = 5888, LDP = 5632;
constexpr int COL_QA = 0, COL_KA = 1024, COL_VA = 1280, COL_QD = 1536, COL_KD = 2560, COL_VD = 3584, COL_Z = 4608;
constexpr float LOG2E = 1.4426950408889634f;
constexpr float QSCALE = 0.125f * LOG2E;
constexpr float DN_ALPHA = 1.189207115002721f;
constexpr float LN_EPS = 1e-5f, RMS_EPS = 1e-6f;

constexpr size_t MiB = 1u << 20;
constexpr size_t WS_CTL = 0, CTL_ZERO_BYTES = 65536;
constexpr size_t WS_WIN = 1 * MiB, WS_WO = 24 * MiB, WS_WUP = 32 * MiB, WS_WDN = 64 * MiB;
constexpr size_t WS_X1B = 96 * MiB;
constexpr size_t WS_GB = 160 * MiB, WS_GG = 161 * MiB, WS_BB = WS_GG + 512 * 1024, WS_BIAS = 162 * MiB;
constexpr size_t WS_PC = 163 * MiB, WS_PD = 164 * MiB, WS_CV = 165 * MiB, WS_ST32 = 166 * MiB, WS_RS = 170 * MiB;
constexpr size_t WS_XB = 192 * MiB, WS_MIX = 448 * MiB;
constexpr size_t WS_PROJ = 256 * MiB;
constexpr size_t WS_OBUF = 448 * MiB;
constexpr size_t WS_H = 192 * MiB;
constexpr size_t WS_END = 512 * MiB;
static_assert(WS_WIN + (size_t)NPROJ * D * 2 <= WS_WO && WS_PROJ + (size_t)M * LDP * 2 <= WS_OBUF && WS_H + (size_t)M * FF * 2 <= WS_END, "d_ws map");
constexpr int CW_BAR = 4096;
constexpr int LATE_END = (FF / 32) * (D / 64) + (D / 32) * (FF / 64) + (D / 32) * (D / 64), LATE_SPLIT = 4096;

constexpr int RING_OFF = 0, RING_BYTES = 162816;
constexpr int LDSCTL_OFF = RING_BYTES, MISC_OFF = LDSCTL_OFF + 320;
constexpr int LDS_BYTES = 163840;

#define GAS __attribute__((address_space(1)))
#define LAS __attribute__((address_space(3)))
typedef unsigned short bf16;
typedef unsigned v4u __attribute__((ext_vector_type(4)));
typedef unsigned v2u __attribute__((ext_vector_type(2)));
typedef float f32x4 __attribute__((ext_vector_type(4)));
typedef float f32x2 __attribute__((ext_vector_type(2)));
typedef GAS unsigned gu32;
#define RLX_AGENT __ATOMIC_RELAXED, __HIP_MEMORY_SCOPE_AGENT
#define LDS_WAIT() asm volatile("s_waitcnt lgkmcnt(0)" ::: "memory")
#define VM_WAIT() asm volatile("s_waitcnt vmcnt(0)" ::: "memory")
__device__ __forceinline__ unsigned f2bf(float f) { unsigned u = __builtin_bit_cast(unsigned, f); return (u + 0x7fffu + ((u >> 16) & 1u)) >> 16; }
__device__ __forceinline__ unsigned pk2(float lo, float hi) { return f2bf(lo) | (f2bf(hi) << 16); }
__device__ __forceinline__ float bflo(unsigned raw) { return __uint_as_float(raw << 16); }
__device__ __forceinline__ float bfhi(unsigned raw) { return __uint_as_float(raw & 0xffff0000u); }
__device__ __forceinline__ float wave_sum(float v) {
#pragma unroll
    for (int o = 1; o < 64; o <<= 1) v += __shfl_xor(v, o);
    return v;
}
__device__ __forceinline__ float silu_f(float v) { return v / (1.f + __expf(-v)); }

#define XB_TMO      128
#define XB_XCNT(j)  (256  + 64 * (j))
#define XB_XSUB(j)  (1280 + 64 * (j))
#define XB_XGEN(j)  (2304 + 64 * (j))
#define XB_TOP      3328
#define XB_TOPGEN   3392
#define XCD_BAR_WORDS 3456
#define XB_SPIN_CAP (1u << 18)

__device__ __forceinline__ unsigned xb_ld(unsigned* p)              { return __hip_atomic_load(p, __ATOMIC_RELAXED, __HIP_MEMORY_SCOPE_AGENT); }
__device__ __forceinline__ unsigned xb_add(unsigned* p, unsigned v) { return __hip_atomic_fetch_add(p, v, __ATOMIC_RELAXED, __HIP_MEMORY_SCOPE_AGENT); }
__device__ __forceinline__ unsigned xb_xcc_id() { return (unsigned)__builtin_amdgcn_s_getreg((3 << 11) | 20) & 0xFu; }
#define XB_SPIN(cond, bar) do { unsigned _sp = 0; while (cond) { __builtin_amdgcn_s_sleep(1); \
    if ((++_sp & 255u) == 0u) { if (xb_ld(&(bar)[XB_TMO])) break; if (_sp > XB_SPIN_CAP) { atomicAdd(&(bar)[XB_TMO], 1u); break; } } } } while (0)

struct XcdBarrier {
    unsigned* bar; unsigned x;
    volatile LAS unsigned* st;
};

__device__ __forceinline__ XcdBarrier xcd_barrier_post(unsigned* bar, volatile LAS unsigned* st) {
    XcdBarrier b; b.bar = bar; b.x = xb_xcc_id(); b.st = st;
    if (threadIdx.x == 0) (void)xb_add(&bar[XB_XCNT(b.x)], 1u);
    return b;
}
__device__ __forceinline__ void xcd_barrier_complete(unsigned* bar, unsigned x, unsigned& nloc, unsigned& nx) {
    const unsigned G = gridDim.x * gridDim.y * gridDim.z;
    unsigned sum, cnt, mine, sp = 0u;
    for (;;) {
        sum = 0u; cnt = 0u; mine = 0u;
#pragma unroll
        for (unsigned j = 0; j < 16; ++j) { const unsigned c = xb_ld(&bar[XB_XCNT(j)]); sum += c; cnt += (c > 0u) ? 1u : 0u; mine = (j == x) ? c : mine; }
        if (sum == G) break;
        __builtin_amdgcn_s_sleep(1);
        if ((++sp & 255u) == 0u) { if (xb_ld(&bar[XB_TMO])) break; if (sp > XB_SPIN_CAP) { atomicAdd(&bar[XB_TMO], 1u); break; } }
    }
    nloc = mine > 0u ? mine : 1u; nx = cnt > 0u ? cnt : 1u;
}

__device__ __forceinline__ void xcd_barrier(const XcdBarrier& b) {
    asm volatile("s_waitcnt vmcnt(0)" ::: "memory");
    __syncthreads();
    if (threadIdx.x == 0) {
        unsigned* bar = b.bar;
        __builtin_amdgcn_s_waitcnt(0);
        unsigned nloc = b.st[0], nx = b.st[1];
        if (nloc == 0u) { xcd_barrier_complete(bar, b.x, nloc, nx); b.st[0] = nloc; b.st[1] = nx; }
        const unsigned old = xb_add(&bar[XB_XSUB(b.x)], 1u);
        const unsigned gen = old / nloc;
        if (old + 1u == (gen + 1u) * nloc) {
            __builtin_amdgcn_fence(__ATOMIC_RELEASE, "agent");
            asm volatile("s_waitcnt vmcnt(0)" ::: "memory");
            const unsigned og = xb_add(&bar[XB_TOP], 1u);
            const unsigned tg = og / nx;
            if (og + 1u == (tg + 1u) * nx) xb_add(&bar[XB_TOPGEN], 1u);
            else XB_SPIN(xb_ld(&bar[XB_TOPGEN]) == tg, bar);
            __builtin_amdgcn_fence(__ATOMIC_ACQUIRE, "agent");
            xb_add(&bar[XB_XGEN(b.x)], 1u);
            asm volatile("s_waitcnt vmcnt(0)" ::: "memory");
        } else {
            XB_SPIN(xb_ld(&bar[XB_XGEN(b.x)]) == gen, bar);
            __builtin_amdgcn_fence(__ATOMIC_ACQUIRE, "agent");
            asm volatile("s_waitcnt vmcnt(0)" ::: "memory");
        }
    }
    __syncthreads();
}

struct Frame {
    LAS unsigned char* lds;
    volatile LAS unsigned* MISC;
    gu32* ctl;
    int tid, lane, wave, vcu, G;
    const float *x, *w_in, *conv_w, *a_log, *dt_bias, *norm_w, *sinks, *rel_bias, *w_o, *ln1_g, *ln1_b, *w_up, *w_down, *ln2_g, *ln2_b;
    float* out;
    bf16 *Win_t, *Wo_t, *Wup_t, *Wdn_t, *xb, *mix, *proj, *x1b, *hb;
    float *gbuf, *gg, *bb, *biasd, *biasT, *obuf, *glast;
    unsigned char *FR, *UU;
    float *pc, *pd, *cv, *dv, *st32, *rowstat;
    bf16* gz;
};

__device__ __forceinline__ void p0_item(const float* W, int K, int N, bf16* WT, int dst_row0, int src_col0, int nvalid, int k0, LAS float* scr, int lane) {
    { const int r_ = lane >> 3, c4 = (lane & 7) * 4;
      f32x4 v[8];
#pragma unroll
      for (int i = 0; i < 8; ++i) v[i] = (c4 < nvalid) ? *(const GAS f32x4*)(W + (size_t)(k0 + 8 * i + r_) * N + src_col0 + c4) : (f32x4){0.f, 0.f, 0.f, 0.f};
#pragma unroll
      for (int i = 0; i < 8; ++i) { LAS float* d = scr + (8 * i + r_) * 33 + c4; d[0] = v[i].x; d[1] = v[i].y; d[2] = v[i].z; d[3] = v[i].w; } }
    LDS_WAIT(); asm volatile("" ::: "memory");
    const int c = lane & 7;
#pragma unroll
    for (int j = 0; j < 4; ++j) { const int n = (lane >> 3) + 8 * j; const LAS float* s = scr + (8 * c) * 33 + n;
        v4u o; o.x = pk2(s[0 * 33], s[1 * 33]); o.y = pk2(s[2 * 33], s[3 * 33]); o.z = pk2(s[4 * 33], s[5 * 33]); o.w = pk2(s[6 * 33], s[7 * 33]);
        *(GAS v4u*)(WT + (size_t)(dst_row0 + n) * K + k0 + 8 * c) = o; }
    LDS_WAIT(); asm volatile("" ::: "memory");
}
__device__ __forceinline__ void p0_item_up(const float* W, const float* g, const float* b, bf16* WT, float* pc, float* pd, int nb, int kb, LAS float* scr, int lane) {
    const int n_ = lane & 31, n0 = 32 * nb, k0 = 64 * kb;
    { const int r_ = lane >> 3, c4 = (lane & 7) * 4;
      f32x4 v[8];
#pragma unroll
      for (int i = 0; i < 8; ++i) v[i] = *(const GAS f32x4*)(W + (size_t)(k0 + 8 * i + r_) * FF + n0 + c4);
#pragma unroll
      for (int i = 0; i < 8; ++i) { LAS float* d = scr + (8 * i + r_) * 33 + c4; d[0] = v[i].x; d[1] = v[i].y; d[2] = v[i].z; d[3] = v[i].w; } }
    LDS_WAIT(); asm volatile("" ::: "memory");
    const int c = lane & 7;
    float gk[8];
#pragma unroll
    for (int e = 0; e < 8; ++e) gk[e] = g[k0 + 8 * c + e];
#pragma unroll
    for (int j = 0; j < 4; ++j) { const int n = (lane >> 3) + 8 * j; const LAS float* s = scr + (8 * c) * 33 + n;
        v4u o; o.x = pk2(s[0 * 33] * gk[0], s[1 * 33] * gk[1]); o.y = pk2(s[2 * 33] * gk[2], s[3 * 33] * gk[3]); o.z = pk2(s[4 * 33] * gk[4], s[5 * 33] * gk[5]); o.w = pk2(s[6 * 33] * gk[6], s[7 * 33] * gk[7]);
        *(GAS v4u*)(WT + (size_t)(n0 + n) * D + k0 + 8 * c) = o; }
    { const int half = lane >> 5; float cs = 0.f, ds = 0.f;
#pragma unroll 8
      for (int i = 0; i < 32; ++i) { const int kk = 32 * half + i; const float w = scr[kk * 33 + n_]; cs += __uint_as_float(f2bf(w * g[k0 + kk]) << 16); ds += w * b[k0 + kk]; }
      cs += __shfl_xor(cs, 32); ds += __shfl_xor(ds, 32);
      if (half == 0) { pc[(size_t)kb * FF + n0 + n_] = cs; pd[(size_t)kb * FF + n0 + n_] = ds; } }
    LDS_WAIT(); asm volatile("" ::: "memory");
}
__device__ __forceinline__ void p0_prologue(Frame& F) {
    LAS float* scr = (LAS float*)(F.lds + RING_OFF + F.wave * 16384);
    const int gw = F.vcu * NWAVES + F.wave, NGW = F.G * NWAVES, lane = F.lane;
    constexpr int NB_IN = NPROJ / 32, I_IN = NB_IN * (D / 64), I_O = (D / 32) * (D / 64), I_UP = (FF / 32) * (D / 64), I_DN = (D / 32) * (FF / 64);
    constexpr int NITEMS = I_IN + I_O + I_UP + I_DN;
    const int nitems = (F.G == 256) ? I_IN : NITEMS;
    for (int it = gw; it < nitems; it += NGW) {
        int r = it;
        if (r < I_IN) { const int nb = r % NB_IN, kb = r / NB_IN, n0 = 32 * nb; int src, nv;
            if (n0 < 4608) { src = n0; nv = 32; } else if (n0 < 5632) { src = n0 + 16; nv = 32; } else if (n0 == 5632) { src = 4608; nv = 16; } else { src = 0; nv = 0; }
            p0_item(F.w_in, D, NIN, F.Win_t, n0, src, nv, 64 * kb, scr, lane); continue; }
        r -= I_IN;
        if (r < I_O) { const int nb = r % (D / 32), kb = r / (D / 32); p0_item(F.w_o, D, D, F.Wo_t, 32 * nb, 32 * nb, 32, 64 * kb, scr, lane); continue; }
        r -= I_O;
        if (r < I_UP) { const int nb = r % (FF / 32), kb = r / (FF / 32); p0_item_up(F.w_up, F.ln1_g, F.ln1_b, F.Wup_t, F.pc, F.pd, nb, kb, scr, lane); continue; }
        r -= I_UP;
        { const int nb = r % (D / 32), kb = r / (D / 32); p0_item(F.w_down, FF, D, F.Wdn_t, 32 * nb, 32 * nb, 32, 64 * kb, scr, lane); }
    }
    for (size_t base = (size_t)gw * 1024; base < (size_t)M * D; base += (size_t)NGW * 1024) {
        f32x4 v[4];
#pragma unroll
        for (int j = 0; j < 4; ++j) v[j] = *(const GAS f32x4*)(F.x + base + j * 256 + lane * 4);
#pragma unroll
        for (int j = 0; j < 4; ++j) { v2u o; o.x = pk2(v[j].x, v[j].y); o.y = pk2(v[j].z, v[j].w); *(GAS v2u*)(F.xb + base + j * 256 + lane * 4) = o; }
    }
    if (blockIdx.x == 0) {
        for (int i = F.tid; i < 2048; i += NWAVES * 64) { const int dist = i >> 4, head = i & 15; int bk;
            if (dist < 16) bk = dist; else { bk = 16 + (int)(logf((float)dist / 16.0f) / 2.0794415416798357f * 16.0f); bk = bk < 31 ? bk : 31; }
            F.biasd[i] = F.rel_bias[bk * 16 + head] * LOG2E; F.biasT[head * 128 + dist] = F.rel_bias[bk * 16 + head] * LOG2E; }
    }
}

__device__ __forceinline__ void late_items(Frame& F, int lo, int hi, int w, int nw) {
    LAS float* scr = (LAS float*)(F.lds + RING_OFF + F.wave * 16384);
    constexpr int I_UP = (FF / 32) * (D / 64), I_DN = (D / 32) * (FF / 64);
    for (int it = lo + w; it < hi; it += nw) {
        if (it < I_UP) { const int nb = it % (FF / 32), kb = it / (FF / 32); p0_item_up(F.w_up, F.ln1_g, F.ln1_b, F.Wup_t, F.pc, F.pd, nb, kb, scr, F.lane); }
        else if (it < I_UP + I_DN) { const int r = it - I_UP, nb = r % (D / 32), kb = r / (D / 32); p0_item(F.w_down, FF, D, F.Wdn_t, 32 * nb, 32 * nb, 32, 64 * kb, scr, F.lane); }
        else { const int r = it - I_UP - I_DN, nb = r % (D / 32), kb = r / (D / 32); p0_item(F.w_o, D, D, F.Wo_t, 32 * nb, 32 * nb, 32, 64 * kb, scr, F.lane); }
    }
}

namespace swa {
typedef short bf16x8 __attribute__((ext_vector_type(8)));
typedef short s16x4 __attribute__((ext_vector_type(4)));
typedef float f32x16 __attribute__((ext_vector_type(16)));
typedef unsigned u32x4 __attribute__((ext_vector_type(4)));
typedef __attribute__((address_space(3))) const unsigned char* lcp;
constexpr int L_K = 0, L_V = 32768, L_BIAS = 65536, L_OST = 73728, L_END = L_OST + 8 * 4096;
__device__ __forceinline__ int crow(int r, int hi) { return (r & 3) + 8 * (r >> 2) + 4 * hi; }
__device__ __forceinline__ unsigned cvtpk(float lo, float hi) { typedef float f2 __attribute__((ext_vector_type(2))); typedef __bf16 b2 __attribute__((ext_vector_type(2)));
    f2 v = {lo, hi}; b2 b = __builtin_convertvector(v, b2); return __builtin_bit_cast(unsigned, b); }
__device__ __forceinline__ s16x4 vtr(lcp p) { typedef short v4i16_t __attribute__((ext_vector_type(4)));
    return __builtin_bit_cast(s16x4, __builtin_amdgcn_ds_read_tr16_b64_v4i16((__attribute__((address_space(3))) v4i16_t*)p)); }
__device__ __forceinline__ void qkt(f32x16& p0, f32x16& p1, lcp Kt, const bf16x8* qr, int r32, int hi) {
    lcp kb = Kt + hi * 1024 + r32 * 16;
    f32x16 z;
#pragma unroll
    for (int i = 0; i < 16; ++i) z[i] = 0.f;
    p0 = z; p1 = z;
#pragma unroll
    for (int d0 = 0; d0 < 4; ++d0) {
        const bf16x8 b0 = *(const __attribute__((address_space(3))) bf16x8*)(kb + d0 * 2048);
        const bf16x8 b1 = *(const __attribute__((address_space(3))) bf16x8*)(kb + d0 * 2048 + 512);
        p0 = __builtin_amdgcn_mfma_f32_32x32x16_bf16(b0, qr[d0], p0, 0, 0, 0);
        p1 = __builtin_amdgcn_mfma_f32_32x32x16_bf16(b1, qr[d0], p1, 0, 0, 0);
    }
}
__device__ __forceinline__ void pv(f32x16* o, lcp vp, u32x4 pw0, u32x4 pw1, u32x4 pw2, u32x4 pw3) {
#pragma unroll
    for (int d0 = 0; d0 < 2; ++d0) {
        s16x4 lo[4], hh[4];
#pragma unroll
        for (int ks = 0; ks < 4; ++ks) { lo[ks] = vtr(vp + d0 * 4096 + ks * 1024); hh[ks] = vtr(vp + d0 * 4096 + ks * 1024 + 512); }
#define SWA_PK(k) (bf16x8){lo[k][0], lo[k][1], lo[k][2], lo[k][3], hh[k][0], hh[k][1], hh[k][2], hh[k][3]}
        o[d0] = __builtin_amdgcn_mfma_f32_32x32x16_bf16(__builtin_bit_cast(bf16x8, pw0), SWA_PK(0), o[d0], 0, 0, 0);
        o[d0] = __builtin_amdgcn_mfma_f32_32x32x16_bf16(__builtin_bit_cast(bf16x8, pw1), SWA_PK(1), o[d0], 0, 0, 0);
        o[d0] = __builtin_amdgcn_mfma_f32_32x32x16_bf16(__builtin_bit_cast(bf16x8, pw2), SWA_PK(2), o[d0], 0, 0, 0);
        o[d0] = __builtin_amdgcn_mfma_f32_32x32x16_bf16(__builtin_bit_cast(bf16x8, pw3), SWA_PK(3), o[d0], 0, 0, 0);
#undef SWA_PK
    }
}
__device__ __forceinline__ void maskbias(f32x16& p0, f32x16& p1, int t, int qabs, int hi, const __attribute__((address_space(3))) float* bh) {
    const float NEG = -1e30f;
    float b0[16], b1[16];
#pragma unroll
    for (int r = 0; r < 16; ++r) { const int d0 = qabs - (64 * t + crow(r, hi)), d1 = d0 - 32; b0[r] = bh[min(max(d0, 0), 127)]; b1[r] = bh[min(max(d1, 0), 127)]; }
    asm volatile("" ::: "memory");
#pragma unroll
    for (int r = 0; r < 16; ++r) {
        const int d0 = qabs - (64 * t + crow(r, hi)), d1 = d0 - 32;
        p0[r] = (d0 >= 0 && d0 < 128) ? p0[r] + b0[r] : NEG;
        p1[r] = (d1 >= 0 && d1 < 128) ? p1[r] + b1[r] : NEG;
    }
}
__device__ __forceinline__ float max16(const f32x16& a) {
    float m0 = fmaxf(fmaxf(a[0], a[1]), fmaxf(a[2], a[3])), m1 = fmaxf(fmaxf(a[4], a[5]), fmaxf(a[6], a[7]));
    float m2 = fmaxf(fmaxf(a[8], a[9]), fmaxf(a[10], a[11])), m3 = fmaxf(fmaxf(a[12], a[13]), fmaxf(a[14], a[15]));
    return fmaxf(fmaxf(m0, m1), fmaxf(m2, m3));
}
__device__ __forceinline__ float expsum16(f32x16& a, float m) {
    float s = 0.f;
#pragma unroll
    for (int r = 0; r < 16; ++r) { a[r] = __builtin_amdgcn_exp2f(a[r] - m); s += a[r]; }
    return s;
}
__device__ __forceinline__ void pack_tile(const f32x16& p0, const f32x16& p1, float inv, u32x4& w0, u32x4& w1, u32x4& w2, u32x4& w3) {
    w0 = (u32x4){cvtpk(p0[0] * inv, p0[1] * inv), cvtpk(p0[2] * inv, p0[3] * inv), cvtpk(p0[4] * inv, p0[5] * inv), cvtpk(p0[6] * inv, p0[7] * inv)};
    w1 = (u32x4){cvtpk(p0[8] * inv, p0[9] * inv), cvtpk(p0[10] * inv, p0[11] * inv), cvtpk(p0[12] * inv, p0[13] * inv), cvtpk(p0[14] * inv, p0[15] * inv)};
    w2 = (u32x4){cvtpk(p1[0] * inv, p1[1] * inv), cvtpk(p1[2] * inv, p1[3] * inv), cvtpk(p1[4] * inv, p1[5] * inv), cvtpk(p1[6] * inv, p1[7] * inv)};
    w3 = (u32x4){cvtpk(p1[8] * inv, p1[9] * inv), cvtpk(p1[10] * inv, p1[11] * inv), cvtpk(p1[12] * inv, p1[13] * inv), cvtpk(p1[14] * inv, p1[15] * inv)};
}
}


namespace swa2 {
using namespace swa;
constexpr int L2_BIAS = 131072, L2_OST = 139264;
__device__ __forceinline__ void glds16(const void* gsrc, unsigned lds_dst) { unsigned keep;
    asm volatile("s_mov_b32 %0, m0\n\ts_mov_b32 m0, %2\n\ts_nop 0\n\tglobal_load_lds_dwordx4 %1, off\n\ts_mov_b32 m0, %0" : "=&s"(keep) : "v"(gsrc), "s"(lds_dst) : "memory"); }
struct QSet { u32x4 q0, q1, q2, q3; };
__device__ __forceinline__ void qload(QSet& q, const void* p) {
    asm volatile("global_load_dwordx4 %0, %4, off\n\tglobal_load_dwordx4 %1, %4, off offset:32\n\tglobal_load_dwordx4 %2, %4, off offset:64\n\tglobal_load_dwordx4 %3, %4, off offset:96"
                 : "=&v"(q.q0), "=&v"(q.q1), "=&v"(q.q2), "=&v"(q.q3) : "v"(p) : "memory"); }
template <int N> __device__ __forceinline__ void qwait(QSet& q) { asm volatile("s_waitcnt vmcnt(%4)" : "+v"(q.q0), "+v"(q.q1), "+v"(q.q2), "+v"(q.q3) : "n"(N) : "memory"); }
}

__device__ __forceinline__ void swa_mfma2(Frame& F, int first, int stride) {
    using namespace swa2;
    const int tid = F.tid, lane = F.lane, r32 = lane & 31, hi = lane >> 5, wid = F.wave;
    LAS unsigned char* L = F.lds;
    LAS float* bl = (LAS float*)(L + L2_BIAS);
    for (int i = tid; i < 2048; i += NWAVES * 64) bl[i] = F.biasT[i];
    const unsigned lds0 = (unsigned)(uintptr_t)L;
#define SWA2_DMA(uu, bufoff) do { const int kvh_ = (uu) & 3, blk_ = ((uu) >> 2) & 15, b_ = (uu) >> 6; const size_t rb_ = (size_t)b_ * SEQ; const int tok0_ = blk_ * 128 - 128; \
        _Pragma("unroll") for (int t = 0; t < 4; ++t) { const int ts_ = (blk_ == 0 && t < 2) ? t + 2 : t; \
            const bf16* ksrc_ = F.proj + (rb_ + tok0_ + 64 * ts_ + lane) * LDP + COL_KA + kvh_ * 64 + wid * 8; \
            const bf16* vsrc_ = F.proj + (rb_ + tok0_ + 64 * ts_ + 16 * (wid & 3) + (lane >> 2)) * LDP + COL_VA + kvh_ * 64 + (wid >> 2) * 32 + (lane & 3) * 8; \
            glds16(ksrc_, (unsigned)__builtin_amdgcn_readfirstlane(lds0 + (bufoff) + t * 8192 + wid * 1024)); \
            glds16(vsrc_, (unsigned)__builtin_amdgcn_readfirstlane(lds0 + (bufoff) + 32768 + t * 8192 + wid * 1024)); } } while (0)
#define SWA2_QPTR(uu, qt) (F.proj + ((size_t)((uu) >> 6) * SEQ + (((uu) >> 2) & 15) * 128 + 64 * (wid & 1) + 32 * (qt) + r32) * LDP + COL_QA + (((uu) & 3) * 4 + (wid >> 1)) * 64 + hi * 8)
    if (first >= 512) { LDS_WAIT(); __syncthreads(); return; }
    QSet qa, qb;
    SWA2_DMA(first, 0); qload(qa, SWA2_QPTR(first, 0));
    int it = 0;
    for (int u = first; u < 512; u += stride, ++it) {
        const int kvh = u & 3, blk = (u >> 2) & 15, b = u >> 6;
        const size_t rowbase = (size_t)b * SEQ;
        const int bufoff = (it & 1) * 65536; const bool has_next = (u + stride < 512);
        const int head = kvh * 4 + (wid >> 1);
        const LAS float* bh = bl + head * 128;
        const float sink2 = F.sinks[head] * LOG2E;
        LDS_WAIT(); asm volatile("" ::: "memory"); __builtin_amdgcn_s_barrier(); asm volatile("" ::: "memory");
#pragma unroll
        for (int qt = 0; qt < 2; ++qt) {
            QSet& qc = (qt == 0) ? qa : qb; QSet& qn = (qt == 0) ? qb : qa;
            if (qt == 0) {
                qload(qn, SWA2_QPTR(u, 1));
                if (has_next) { SWA2_DMA(u + stride, 65536 - bufoff); qwait<12>(qc); } else qwait<4>(qc);
                asm volatile("" ::: "memory"); __builtin_amdgcn_s_barrier(); asm volatile("" ::: "memory");
            } else {
                if (has_next) { qload(qn, SWA2_QPTR(u + stride, 0)); qwait<12>(qc); } else qwait<0>(qc);
            }
            const int q0 = 64 * (wid & 1) + 32 * qt, qabs = q0 + r32 + 128;
            bf16x8 qr[4] = {__builtin_bit_cast(bf16x8, qc.q0), __builtin_bit_cast(bf16x8, qc.q1), __builtin_bit_cast(bf16x8, qc.q2), __builtin_bit_cast(bf16x8, qc.q3)};
            const int tlo0 = (q0 < 64) ? 0 : 1, thi = tlo0 + 2, tlo = (blk == 0 && tlo0 < 2) ? 2 : tlo0;
            f32x16 P[3][2];
            float mx = -1e30f;
#pragma unroll
            for (int i = 0; i < 3; ++i) {
                const int t = tlo + i;
                if (t <= thi) { qkt(P[i][0], P[i][1], (lcp)(L + bufoff + t * 8192), qr, r32, hi); maskbias(P[i][0], P[i][1], t, qabs, hi, bh);
                    mx = fmaxf(mx, fmaxf(max16(P[i][0]), max16(P[i][1]))); }
            }
            { auto rr = __builtin_amdgcn_permlane32_swap(__float_as_uint(mx), __float_as_uint(mx), false, false); mx = fmaxf(__uint_as_float(rr[0]), __uint_as_float(rr[1])); }
            mx = fmaxf(mx, sink2);
            float l = 0.f;
#pragma unroll
            for (int i = 0; i < 3; ++i) { if (tlo + i <= thi) { l += expsum16(P[i][0], mx); l += expsum16(P[i][1], mx); } }
            { auto rr = __builtin_amdgcn_permlane32_swap(__float_as_uint(l), __float_as_uint(l), false, false); l = __uint_as_float(rr[0]) + __uint_as_float(rr[1]); }
            l += __builtin_amdgcn_exp2f(sink2 - mx);
            const float inv = __builtin_amdgcn_rcpf(l);
            f32x16 o[2];
#pragma unroll
            for (int i = 0; i < 16; ++i) { o[0][i] = 0.f; o[1][i] = 0.f; }
            lcp vp0 = (lcp)(L + bufoff + 32768) + ((lane >> 4) & 1) * 32 + (lane & 3) * 8 + (4 * hi + ((lane & 15) >> 2)) * 64;
#pragma unroll
            for (int i = 0; i < 3; ++i) {
                const int t = tlo + i;
                if (t <= thi) { u32x4 w0, w1, w2, w3; pack_tile(P[i][0], P[i][1], inv, w0, w1, w2, w3); pv(o, vp0 + t * 8192, w0, w1, w2, w3); }
            }
            LAS unsigned short* stg = (LAS unsigned short*)(L + L2_OST + wid * 2048);
            bf16* Ow = F.mix + (rowbase + blk * 128 + q0) * D + head * 64;
#pragma unroll
            for (int d0 = 0; d0 < 2; ++d0) {
#pragma unroll
                for (int r = 0; r < 16; ++r) stg[crow(r, hi) * 32 + r32] = (unsigned short)f2bf(o[d0][r]);
                LDS_WAIT(); asm volatile("" ::: "memory");
#pragma unroll
                for (int k = 0; k < 2; ++k) { const int id = k * 64 + lane, row = id >> 2, ch = id & 3; const u32x4 v = *(const LAS u32x4*)(stg + row * 32 + ch * 8); *(GAS u32x4*)(Ow + (size_t)row * D + d0 * 32 + ch * 8) = v; }
                LDS_WAIT(); asm volatile("" ::: "memory");
            }
        }
    }
    LDS_WAIT(); __syncthreads();
#undef SWA2_DMA
#undef SWA2_QPTR
}

namespace gdn {
typedef short bf16x8 __attribute__((ext_vector_type(8)));
typedef float f32x16 __attribute__((ext_vector_type(16)));
typedef float f32x4v __attribute__((ext_vector_type(4)));
typedef unsigned u32x4 __attribute__((ext_vector_type(4)));
typedef unsigned u32x2 __attribute__((ext_vector_type(2)));
constexpr int FRB = 54 * 1024, UUB = 16 * 1024;
constexpr int LA = 0, LG = 16384, LQ = 17408, LK = 34816, LV = 52224, LXU = 69632, LXW = 87040, LAT = 104448, LPREP_END = LAT + 64 * 72 * 2;
constexpr int RS = 136;
__device__ __forceinline__ int crow(int r, int hi) { return (r & 3) + 8 * (r >> 2) + 4 * hi; }
__device__ __forceinline__ unsigned cvtpk(float lo, float hi) { typedef float f2 __attribute__((ext_vector_type(2))); typedef __bf16 b2 __attribute__((ext_vector_type(2)));
    f2 v = {lo, hi}; b2 b = __builtin_convertvector(v, b2); return __builtin_bit_cast(unsigned, b); }
__device__ __forceinline__ bf16x8 pack8(const f32x16& x, int s) {
    u32x4 p = {cvtpk(x[8 * s], x[8 * s + 1]), cvtpk(x[8 * s + 2], x[8 * s + 3]), cvtpk(x[8 * s + 4], x[8 * s + 5]), cvtpk(x[8 * s + 6], x[8 * s + 7])};
    return __builtin_bit_cast(bf16x8, p);
}
}


namespace gdn2 {
using namespace gdn;
typedef __attribute__((address_space(3))) const unsigned char* lcp;
typedef short s16x4 __attribute__((ext_vector_type(4)));
constexpr int P2Q = 0, P2K = 17408, P2V = 34816, P2A = 52224, P2T = 69632, P2TU = 87040, P2TW = 96256, P2G = 105472, P2_END = P2G + 4096;
constexpr int AS = 68, TS = 72;
#define LDS_OPAQUE(type, ptr) ({ unsigned a_ = (unsigned)(uintptr_t)(ptr); asm volatile("" : "+v"(a_)); (type)a_; })
__device__ __forceinline__ s16x4 vtr(lcp p) { typedef short v4i16_t __attribute__((ext_vector_type(4)));
    return __builtin_bit_cast(s16x4, __builtin_amdgcn_ds_read_tr16_b64_v4i16((__attribute__((address_space(3))) v4i16_t*)p)); }
template <int CTRL> __device__ __forceinline__ float dppf(float x) { return __builtin_bit_cast(float, __builtin_amdgcn_mov_dpp(__builtin_bit_cast(int, x), CTRL, 0xf, 0xf, true)); }
__device__ __forceinline__ float wsum_dpp(float x) {
    x += dppf<0xB1>(x); x += dppf<0x4E>(x); x += dppf<0x141>(x); x += dppf<0x128>(x);
    auto s = __builtin_amdgcn_permlane16_swap(__float_as_uint(x), __float_as_uint(x), false, false);
    x = __uint_as_float(s[0]) + __uint_as_float(s[1]);
    auto t = __builtin_amdgcn_permlane32_swap(__float_as_uint(x), __float_as_uint(x), false, false);
    return __uint_as_float(t[0]) + __uint_as_float(t[1]);
}
__device__ __forceinline__ void wsum_dpp16(float (&a)[8], float (&b)[8]) {
#pragma unroll
    for (int j = 0; j < 8; ++j) { a[j] += dppf<0xB1>(a[j]); b[j] += dppf<0xB1>(b[j]); }
#pragma unroll
    for (int j = 0; j < 8; ++j) { a[j] += dppf<0x4E>(a[j]); b[j] += dppf<0x4E>(b[j]); }
#pragma unroll
    for (int j = 0; j < 8; ++j) { a[j] += dppf<0x141>(a[j]); b[j] += dppf<0x141>(b[j]); }
#pragma unroll
    for (int j = 0; j < 8; ++j) { a[j] += dppf<0x128>(a[j]); b[j] += dppf<0x128>(b[j]); }
#pragma unroll
    for (int j = 0; j < 8; ++j) { auto s = __builtin_amdgcn_permlane16_swap(__float_as_uint(a[j]), __float_as_uint(a[j]), false, false); a[j] = __uint_as_float(s[0]) + __uint_as_float(s[1]);
                                  auto t = __builtin_amdgcn_permlane16_swap(__float_as_uint(b[j]), __float_as_uint(b[j]), false, false); b[j] = __uint_as_float(t[0]) + __uint_as_float(t[1]); }
#pragma unroll
    for (int j = 0; j < 8; ++j) { auto s = __builtin_amdgcn_permlane32_swap(__float_as_uint(a[j]), __float_as_uint(a[j]), false, false); a[j] = __uint_as_float(s[0]) + __uint_as_float(s[1]);
                                  auto t = __builtin_amdgcn_permlane32_swap(__float_as_uint(b[j]), __float_as_uint(b[j]), false, false); b[j] = __uint_as_float(t[0]) + __uint_as_float(t[1]); }
}
__device__ __forceinline__ bf16x8 cat8(s16x4 a, s16x4 b) { return (bf16x8){a[0], a[1], a[2], a[3], b[0], b[1], b[2], b[3]}; }
template <int B> __device__ __forceinline__ void tchain(const __attribute__((address_space(3))) float* Al, const __attribute__((address_space(3))) float* Tf,
                                                        __attribute__((address_space(3))) unsigned short* Tbu, __attribute__((address_space(3))) unsigned short* Tbw,
                                                        const __attribute__((address_space(3))) float* Gs, int lane) {
    const int i = lane & 15, g = lane >> 4;
    typedef const __attribute__((address_space(3))) float* lfp; typedef __attribute__((address_space(3))) unsigned short* lsp;
    lfp Alp = LDS_OPAQUE(lfp, Al + i * AS + 4 * g), Tfp = LDS_OPAQUE(lfp, Tf + i * AS + 4 * g), Tfb = LDS_OPAQUE(lfp, Tf + 4 * g * AS + i);
    lsp Tup = LDS_OPAQUE(lsp, Tbu + 4 * g * TS + i), Twp = LDS_OPAQUE(lsp, Tbw + 4 * g * TS + i);
    f32x4v Y[4];
    float bd[4];
#pragma unroll
    for (int ks = 0; ks < 4; ++ks) bd[ks] = Tfb[(16 * B + ks) * AS + 16 * B];
    const float cu = Gs[64 + 16 * B + i], cw = Gs[256 + 16 * B + i];
#pragma unroll
    for (int a = B + 1; a < 4; ++a) {
        f32x4v P = {0.f, 0.f, 0.f, 0.f};
        { const f32x4v ao = *(const __attribute__((address_space(3))) f32x4v*)(Alp + (16 * a) * AS + 16 * B);
#pragma unroll
          for (int ks = 0; ks < 4; ++ks) P = __builtin_amdgcn_mfma_f32_16x16x4f32(ao[ks], bd[ks], P, 0, 0, 0); }
#pragma unroll
        for (int m = B + 1; m < a; ++m) { const f32x4v ao = *(const __attribute__((address_space(3))) f32x4v*)(Alp + (16 * a) * AS + 16 * m);
#pragma unroll
            for (int ks = 0; ks < 4; ++ks) P = __builtin_amdgcn_mfma_f32_16x16x4f32(ao[ks], Y[m][ks], P, 0, 0, 0); }
        const f32x4v dop = *(const __attribute__((address_space(3))) f32x4v*)(Tfp + (16 * a) * AS + 16 * a);
        f32x4v y = {0.f, 0.f, 0.f, 0.f};
#pragma unroll
        for (int ks = 0; ks < 4; ++ks) y = __builtin_amdgcn_mfma_f32_16x16x4f32(dop[ks], P[ks], y, 0, 0, 0);
        Y[a] = -y;
#pragma unroll
        for (int r = 0; r < 4; ++r) { Tup[(16 * a + r) * TS + 16 * B] = (unsigned short)f2bf(Y[a][r] * cu); Twp[(16 * a + r) * TS + 16 * B] = (unsigned short)f2bf(Y[a][r] * cw); }
    }
}
}

__device__ __forceinline__ void gdn_prep2(Frame& F) {
    using namespace gdn2;
    const int lane = F.lane, wave = F.wave;
    LAS unsigned char* L = F.lds;
    LAS unsigned short* qb = (LAS unsigned short*)(L + P2Q); LAS unsigned short* kb = (LAS unsigned short*)(L + P2K); LAS unsigned short* vb = (LAS unsigned short*)(L + P2V);
    LAS float* Al = (LAS float*)(L + P2A); LAS float* Tf = (LAS float*)(L + P2T);
    LAS unsigned short* Tbu = (LAS unsigned short*)(L + P2TU); LAS unsigned short* Tbw = (LAS unsigned short*)(L + P2TW);
    LAS float* Gs0 = (LAS float*)(L + P2G);
    const int r32 = lane & 31, hh = lane >> 5;
    for (int e = F.tid; e < 64 * 64; e += NWAVES * 64) { const int row = e >> 6, col = e & 63; if ((col >> 4) > (row >> 4)) { Tbu[row * TS + col] = 0; Tbw[row * TS + col] = 0; } }
    int hcur = -1;
    const f32x2 nwv = *(const GAS f32x2*)(F.norm_w + 2 * lane);
    f32x2 cw[4][3];
#pragma unroll
    for (int w = 0; w < 4; ++w)
#pragma unroll
        for (int p = 0; p < 3; ++p) cw[w][p] = (f32x2){0.f, 0.f};
    unsigned raw[11][3], zraw[8];
#define GDN2_ISSUE_LOADS(chx) do { const int n_ = (chx) & 31, h_ = ((chx) >> 5) & 7, b_ = (chx) >> 8; \
        const bf16* base_ = F.proj + (size_t)(b_ * SEQ + n_ * 64 + 8 * wave) * LDP + COL_QD + h_ * 128 + 2 * lane; \
        _Pragma("unroll") for (int r = 0; r < 11; ++r) { const bool ok_ = (n_ * 64 + 8 * wave - 3 + r) >= 0; \
            _Pragma("unroll") for (int p = 0; p < 3; ++p) raw[r][p] = ok_ ? *(const GAS unsigned*)(base_ + (ptrdiff_t)(r - 3) * LDP + p * 1024) : 0u; } \
        _Pragma("unroll") for (int j = 0; j < 8; ++j) zraw[j] = *(const GAS unsigned*)(base_ + (size_t)j * LDP + (COL_Z - COL_QD)); } while (0)
#define GDN2_GATES(dst, chx, garx, gbrx) do { const int h_ = ((chx) >> 5) & 7; const float ar_ = (garx) + F.dt_bias[h_]; \
        const float sp_ = fmaxf(ar_, 0.f) + log1pf(expf(-fabsf(ar_))); float G_ = -expf(F.a_log[h_]) * sp_; \
        _Pragma("unroll") for (int o = 1; o < 64; o <<= 1) { const float t_ = __shfl_up(G_, o); if (lane >= o) G_ += t_; } \
        const float Gl_ = __shfl(G_, 63), be_ = 1.f / (1.f + expf(-(gbrx))), eg_ = expf(G_); \
        (dst)[lane] = G_; (dst)[64 + lane] = be_; (dst)[128 + lane] = eg_; (dst)[192 + lane] = expf(Gl_ - G_); (dst)[256 + lane] = be_ * eg_; \
        if (lane == 63) F.glast[(chx)] = eg_; } while (0)
#define GDN2_GATE_LOADS(chx) do { const int n_ = (chx) & 31, h_ = ((chx) >> 5) & 7, b_ = (chx) >> 8; const float* gp_ = F.gbuf + (size_t)(b_ * SEQ + n_ * 64 + lane) * 16 + h_; \
        gar = *(const GAS float*)gp_; gbr = *(const GAS float*)(gp_ + 8); } while (0)
    float gar = 0.f, gbr = 0.f;
    if (F.vcu < 2048) { GDN2_ISSUE_LOADS(F.vcu); if (wave == 7) { GDN2_GATE_LOADS(F.vcu); GDN2_GATES(Gs0, F.vcu, gar, gbr); } }
    int itc = 0;
    for (int ch = F.vcu; ch < 2048; ch += F.G) {
        const int n = ch & 31, h = (ch >> 5) & 7, b = ch >> 8;
        LAS float* Gs = Gs0 + (itc & 1) * 512; LAS float* Gn = Gs0 + ((itc & 1) ^ 1) * 512; ++itc;
        if (h != hcur) { hcur = h;
#pragma unroll
            for (int w = 0; w < 4; ++w)
#pragma unroll
                for (int p = 0; p < 3; ++p) cw[w][p] = *(const GAS f32x2*)(F.conv_w + w * 3072 + p * 1024 + h * 128 + 2 * lane); }
        {
            f32x2 xr[11][3];
#pragma unroll
            for (int r = 0; r < 11; ++r)
#pragma unroll
                for (int p = 0; p < 3; ++p) xr[r][p] = (f32x2){bflo(raw[r][p]), bfhi(raw[r][p])};
            f32x2 a[8][3]; float sq[8], sk[8];
#pragma unroll
            for (int j = 0; j < 8; ++j) {
#pragma unroll
                for (int p = 0; p < 3; ++p) {
                    f32x2 c = xr[j][p] * cw[0][p]; c = xr[j + 1][p] * cw[1][p] + c; c = xr[j + 2][p] * cw[2][p] + c; c = xr[j + 3][p] * cw[3][p] + c;
                    const float e0 = __builtin_amdgcn_exp2f(c.x * -LOG2E), e1 = __builtin_amdgcn_exp2f(c.y * -LOG2E);
                    a[j][p] = (f32x2){c.x * __builtin_amdgcn_rcpf(1.f + e0), c.y * __builtin_amdgcn_rcpf(1.f + e1)};
                }
                sq[j] = a[j][0].x * a[j][0].x + a[j][0].y * a[j][0].y; sk[j] = a[j][1].x * a[j][1].x + a[j][1].y * a[j][1].y;
            }
            wsum_dpp16(sq, sk);
#pragma unroll
            for (int j = 0; j < 8; ++j) {
                const float rq = __builtin_amdgcn_rsqf(sq[j] + RMS_EPS) * 0.08838834764831845f, rk = __builtin_amdgcn_rsqf(sk[j] + RMS_EPS);
                const int i = 8 * wave + j;
                *(LAS unsigned*)(qb + i * RS + 2 * lane) = cvtpk(a[j][0].x * rq, a[j][0].y * rq);
                *(LAS unsigned*)(kb + i * RS + 2 * lane) = cvtpk(a[j][1].x * rk, a[j][1].y * rk);
                *(LAS unsigned*)(vb + i * RS + 2 * lane) = cvtpk(a[j][2].x, a[j][2].y);
            }
            bf16* gzp = F.gz + (size_t)(b * SEQ + n * 64 + 8 * wave) * 1024 + h * 128 + 2 * lane;
#pragma unroll
            for (int j = 0; j < 8; ++j) { const float z0 = bflo(zraw[j]), z1 = bfhi(zraw[j]);
                const float s0 = z0 * __builtin_amdgcn_rcpf(1.f + __builtin_amdgcn_exp2f(z0 * -LOG2E)), s1 = z1 * __builtin_amdgcn_rcpf(1.f + __builtin_amdgcn_exp2f(z1 * -LOG2E));
                *(GAS unsigned*)(gzp + (size_t)j * 1024) = cvtpk(s0 * nwv.x, s1 * nwv.y); }
        }
        if (ch + F.G < 2048) { GDN2_ISSUE_LOADS(ch + F.G); if (wave == 7) GDN2_GATE_LOADS(ch + F.G); }
        LDS_WAIT(); asm volatile("" ::: "memory"); __builtin_amdgcn_s_barrier(); asm volatile("" ::: "memory");
        unsigned char* FRc = F.FR + (size_t)ch * FRB;
        if (wave < 3) {
            const int jb = (wave == 2) ? 1 : 0, ib = (wave == 0) ? 0 : 1;
            f32x16 X;
#pragma unroll
            for (int e = 0; e < 16; ++e) X[e] = 0.f;
            const LAS unsigned short* Am = kb + (32 * jb + r32) * RS + 8 * hh; const LAS unsigned short* Bm = qb + (32 * ib + r32) * RS + 8 * hh;
#pragma unroll
            for (int ks = 0; ks < 8; ++ks) X = __builtin_amdgcn_mfma_f32_32x32x16_bf16(*(const LAS bf16x8*)(Am + 16 * ks), *(const LAS bf16x8*)(Bm + 16 * ks), X, 0, 0, 0);
            const int it = 32 * ib + r32; const float Gi = Gs[it];
#pragma unroll
            for (int e = 0; e < 16; ++e) { const int jt = 32 * jb + crow(e, hh); X[e] = (it >= jt) ? X[e] * __builtin_amdgcn_exp2f((Gi - Gs[jt]) * LOG2E) : 0.f; }
            const int f0 = (wave == 0) ? 32 : (wave == 1) ? 34 : 36;
            *(GAS bf16x8*)(FRc + f0 * 1024 + lane * 16) = pack8(X, 0);
            *(GAS bf16x8*)(FRc + (f0 + 1) * 1024 + lane * 16) = pack8(X, 1);
        } else {
            const int fr = lane & 15, fq = lane >> 4;
            for (int jj = wave - 3; jj < 10; jj += 5) {
                const int bi = (jj >= 6) ? 3 : (jj >= 3) ? 2 : (jj >= 1) ? 1 : 0, bj = jj - (bi * (bi + 1)) / 2;
                const LAS unsigned short* Am = kb + (16 * bi + fr) * RS + 8 * fq; const LAS unsigned short* Bm = kb + (16 * bj + fr) * RS + 8 * fq;
                f32x4v acc = {0.f, 0.f, 0.f, 0.f};
#pragma unroll
                for (int ks = 0; ks < 4; ++ks) acc = __builtin_amdgcn_mfma_f32_16x16x32_bf16(*(const LAS bf16x8*)(Am + 32 * ks), *(const LAS bf16x8*)(Bm + 32 * ks), acc, 0, 0, 0);
                const int jt = 16 * bj + fr; const float Gj = Gs[jt];
#pragma unroll
                for (int r = 0; r < 4; ++r) { const int it = 16 * bi + 4 * fq + r; Al[it * AS + jt] = (it > jt) ? acc[r] * Gs[64 + it] * __builtin_amdgcn_exp2f((Gs[it] - Gj) * LOG2E) : 0.f; }
            }
        }
        LDS_WAIT(); asm volatile("" ::: "memory"); __builtin_amdgcn_s_barrier(); asm volatile("" ::: "memory");
        if (wave < 3) {
            const int bb = lane >> 4, c = lane & 15;
            float x[16];
#pragma unroll
            for (int i = 0; i < 16; ++i) x[i] = (i == c) ? 1.f : 0.f;
            const LAS float* Ab = LDS_OPAQUE(const LAS float*, Al + (16 * bb) * AS + 16 * bb);
            LAS float* Tfc = LDS_OPAQUE(LAS float*, Tf + (16 * bb) * AS + 16 * bb + c);
            LAS unsigned short* Tuc = LDS_OPAQUE(LAS unsigned short*, Tbu + (16 * bb) * TS + 16 * bb + c); LAS unsigned short* Twc = LDS_OPAQUE(LAS unsigned short*, Tbw + (16 * bb) * TS + 16 * bb + c);
#pragma unroll
            for (int i = 1; i < 16; ++i) {
                float s = 0.f;
#pragma unroll
                for (int j4 = 0; j4 < (i + 3) / 4; ++j4) { const f32x4v a4 = *(const LAS f32x4v*)(Ab + i * AS + 4 * j4);
#pragma unroll
                    for (int e = 0; e < 4; ++e) if (4 * j4 + e < i) s += a4[e] * x[4 * j4 + e]; }
                x[i] -= s;
            }
#pragma unroll
            for (int i = 0; i < 16; ++i) Tfc[i * AS] = x[i];
            if (wave == 0) { const float cu = Gs[64 + 16 * bb + c], cwv = Gs[256 + 16 * bb + c];
#pragma unroll
                for (int i = 0; i < 16; ++i) { Tuc[i * TS] = (unsigned short)f2bf(x[i] * cu); Twc[i * TS] = (unsigned short)f2bf(x[i] * cwv); } }
            LDS_WAIT(); asm volatile("" ::: "memory");
            if (wave == 0) tchain<0>(Al, Tf, Tbu, Tbw, Gs, lane); else if (wave == 1) tchain<1>(Al, Tf, Tbu, Tbw, Gs, lane); else tchain<2>(Al, Tf, Tbu, Tbw, Gs, lane);
        } else {
            for (int job = wave - 3; job < 32; job += 5) {
                u32x4 o;
                if (job < 16) {
                    const int ib = job >> 3, s = job & 7, row = 32 * ib + r32; const float eg = Gs[128 + row];
                    const u32x2 a = *(const LAS u32x2*)(qb + row * RS + 16 * s + 4 * hh), c = *(const LAS u32x2*)(qb + row * RS + 16 * s + 8 + 4 * hh);
                    o.x = cvtpk(bflo(a.x) * eg, bfhi(a.x) * eg); o.y = cvtpk(bflo(a.y) * eg, bfhi(a.y) * eg); o.z = cvtpk(bflo(c.x) * eg, bfhi(c.x) * eg); o.w = cvtpk(bflo(c.y) * eg, bfhi(c.y) * eg);
                    *(GAS u32x4*)(FRc + (16 + job) * 1024 + lane * 16) = o;
                } else {
                    const int db = (job - 16) >> 2, s = (job - 16) & 3;
                    lcp p = (lcp)kb + ((16 * s + 4 * hh + ((lane & 15) >> 2)) * RS + 32 * db + 16 * ((lane >> 4) & 1) + 4 * (lane & 3)) * 2;
                    const s16x4 lo = vtr(p), hi = vtr(p + 8 * RS * 2);
                    const f32x4v f0 = *(const LAS f32x4v*)(Gs + 192 + 16 * s + 4 * hh), f1 = *(const LAS f32x4v*)(Gs + 192 + 16 * s + 8 + 4 * hh);
                    o.x = cvtpk(__uint_as_float((unsigned)(unsigned short)lo[0] << 16) * f0[0], __uint_as_float((unsigned)(unsigned short)lo[1] << 16) * f0[1]);
                    o.y = cvtpk(__uint_as_float((unsigned)(unsigned short)lo[2] << 16) * f0[2], __uint_as_float((unsigned)(unsigned short)lo[3] << 16) * f0[3]);
                    o.z = cvtpk(__uint_as_float((unsigned)(unsigned short)hi[0] << 16) * f1[0], __uint_as_float((unsigned)(unsigned short)hi[1] << 16) * f1[1]);
                    o.w = cvtpk(__uint_as_float((unsigned)(unsigned short)hi[2] << 16) * f1[2], __uint_as_float((unsigned)(unsigned short)hi[3] << 16) * f1[3]);
                    *(GAS u32x4*)(FRc + (38 + job - 16) * 1024 + lane * 16) = o;
                }
            }
            if (wave == 7 && ch + F.G < 2048) GDN2_GATES(Gn, ch + F.G, gar, gbr);
        }
        LDS_WAIT(); asm volatile("" ::: "memory"); __builtin_amdgcn_s_barrier(); asm volatile("" ::: "memory");
        {
            const int ib = wave & 1, cs = wave >> 1, q = (lane & 15) >> 2;
            const int coff = 32 * cs + 16 * ((lane >> 4) & 1) + 4 * (lane & 3);
            f32x16 au, aw;
#pragma unroll
            for (int e = 0; e < 16; ++e) { au[e] = 0.f; aw[e] = 0.f; }
            const LAS unsigned short* tu = Tbu + (32 * ib + r32) * TS + 8 * hh; const LAS unsigned short* tw = Tbw + (32 * ib + r32) * TS + 8 * hh;
#pragma unroll
            for (int s = 0; s < 4; ++s) {
                if (s < 2 || ib == 1) {
                    lcp pv_ = (lcp)vb + ((16 * s + 8 * hh + q) * RS + coff) * 2; lcp pk_ = (lcp)kb + ((16 * s + 8 * hh + q) * RS + coff) * 2;
                    const bf16x8 vf = cat8(vtr(pv_), vtr(pv_ + 4 * RS * 2)), kf = cat8(vtr(pk_), vtr(pk_ + 4 * RS * 2));
                    au = __builtin_amdgcn_mfma_f32_32x32x16_bf16(*(const LAS bf16x8*)(tu + 16 * s), vf, au, 0, 0, 0);
                    aw = __builtin_amdgcn_mfma_f32_32x32x16_bf16(kf, *(const LAS bf16x8*)(tw + 16 * s), aw, 0, 0, 0);
                }
            }
            unsigned char* Uc = F.UU + (size_t)ch * UUB + ((cs * 2 + ib) * 2) * 1024 + lane * 16;
            *(GAS bf16x8*)(Uc) = pack8(au, 0); *(GAS bf16x8*)(Uc + 1024) = pack8(au, 1);
#pragma unroll
            for (int e = 0; e < 16; ++e) aw[e] = -aw[e];
            *(GAS bf16x8*)(FRc + (ib * 8 + 2 * cs) * 1024 + lane * 16) = pack8(aw, 0);
            *(GAS bf16x8*)(FRc + (ib * 8 + 2 * cs + 1) * 1024 + lane * 16) = pack8(aw, 1);
        }
        LDS_WAIT(); asm volatile("" ::: "memory"); __builtin_amdgcn_s_barrier(); asm volatile("" ::: "memory");
    }
#undef GDN2_ISSUE_LOADS
#undef GDN2_GATES
#undef GDN2_GATE_LOADS
}


__device__ __forceinline__ void gdn_scan2(Frame& F, int first, int stride) {
    using namespace gdn;
    const int lane = F.lane, wave = F.wave;
    LAS unsigned char* L = F.lds;
    constexpr int STG = 2 * FRB, STGB = 64 * RS * 2;
    for (int bh = first; bh < 64; bh += stride) {
        const int ch0 = bh * 32, b = bh >> 3, h = bh & 7;
        LDS_WAIT(); asm volatile("" ::: "memory"); __builtin_amdgcn_s_barrier(); asm volatile("" ::: "memory");
        if (wave >= 4) {
            const int lw = wave - 4;
            { const unsigned char* src = F.FR + (size_t)ch0 * FRB;
              for (int p = lw; p < 54; p += 4) __builtin_amdgcn_global_load_lds((const GAS unsigned*)(src + p * 1024 + lane * 16), (LAS unsigned*)(L + p * 1024), 16, 0, 0); }
            u32x2 zc[8], zn[8];
#pragma unroll
            for (int i = 0; i < 8; ++i) { zc[i] = (u32x2){0u, 0u}; zn[i] = (u32x2){0u, 0u}; }
            const int ehalf = lane >> 5, ecol = (lane & 31) * 4;
            VM_WAIT();
            asm volatile("" ::: "memory"); __builtin_amdgcn_s_barrier(); asm volatile("" ::: "memory");
#pragma unroll 1
            for (int c = 0; c <= 32; ++c) {
                if (c + 1 < 32) {
                    const unsigned char* src = F.FR + (size_t)(ch0 + c + 1) * FRB; LAS unsigned char* dst = L + ((c + 1) & 1) * FRB;
                    for (int p = lw; p < 54; p += 4) __builtin_amdgcn_global_load_lds((const GAS unsigned*)(src + p * 1024 + lane * 16), (LAS unsigned*)(dst + p * 1024), 16, 0, 0);
                }
                if (c < 32) {
                    const bf16* zp = F.gz + (size_t)(b * SEQ + 64 * c + 16 * lw + ehalf) * 1024 + h * 128 + ecol;
#pragma unroll
                    for (int i = 0; i < 8; ++i) zn[i] = *(const GAS u32x2*)(zp + (size_t)(2 * i) * 1024);
                }
                if (c > 0) {
                    const LAS unsigned short* st = (const LAS unsigned short*)(L + STG + ((c - 1) & 1) * STGB) + (16 * lw + ehalf) * RS + ecol;
                    bf16* mp = F.mix + (size_t)(b * SEQ + 64 * (c - 1) + 16 * lw + ehalf) * D + 1024 + h * 128 + ecol;
#pragma unroll
                    for (int i = 0; i < 8; ++i) {
                        const u32x2 ov = *(const LAS u32x2*)(st + (2 * i) * RS);
                        const float o0 = bflo(ov.x), o1 = bfhi(ov.x), o2 = bflo(ov.y), o3 = bfhi(ov.y);
                        float ss = (o0 * o0 + o1 * o1) + (o2 * o2 + o3 * o3);
                        ss += gdn2::dppf<0xB1>(ss); ss += gdn2::dppf<0x4E>(ss); ss += gdn2::dppf<0x141>(ss); ss += gdn2::dppf<0x128>(ss);
                        { auto sw = __builtin_amdgcn_permlane16_swap(__float_as_uint(ss), __float_as_uint(ss), false, false); ss = __uint_as_float(sw[0]) + __uint_as_float(sw[1]); }
                        const float r = __builtin_amdgcn_rsqf(ss * (1.f / 128.f) + RMS_EPS);
                        u32x2 w; w.x = cvtpk(o0 * r * bflo(zc[i].x), o1 * r * bfhi(zc[i].x)); w.y = cvtpk(o2 * r * bflo(zc[i].y), o3 * r * bfhi(zc[i].y));
                        *(GAS u32x2*)(mp + (size_t)(2 * i) * D) = w;
                    }
                }
                VM_WAIT();
#pragma unroll
                for (int i = 0; i < 8; ++i) { asm volatile("" : "+v"(zn[i])); zc[i] = zn[i]; }
                LDS_WAIT();
                asm volatile("" ::: "memory"); __builtin_amdgcn_s_barrier(); asm volatile("" ::: "memory");
            }
        } else {
            __builtin_amdgcn_s_setprio(2);
            asm volatile("" ::: "memory"); __builtin_amdgcn_s_barrier(); asm volatile("" ::: "memory");
            f32x16 S[4]; bf16x8 Sb[4][2];
#pragma unroll
            for (int d = 0; d < 4; ++d) {
#pragma unroll
                for (int i = 0; i < 16; ++i) S[d][i] = 0.f;
                Sb[d][0] = (bf16x8){0, 0, 0, 0, 0, 0, 0, 0}; Sb[d][1] = (bf16x8){0, 0, 0, 0, 0, 0, 0, 0};
            }
            const unsigned char* up0 = F.UU + (size_t)ch0 * UUB + (wave * 4) * 1024 + lane * 16;
            u32x4 uc[4]; float glc = F.glast[ch0];
#pragma unroll
            for (int k = 0; k < 4; ++k) uc[k] = *(const GAS u32x4*)(up0 + k * 1024);
            const int hh = lane >> 5, n32 = lane & 31;
#pragma unroll 1
            for (int c = 0; c <= 32; ++c) {
                if (c < 32) {
                    const LAS unsigned char* buf = L + (c & 1) * FRB + lane * 16;
#define GFRAG(f) (*(const LAS bf16x8*)(buf + (f) * 1024))
                    f32x16 vn[2], o[2];
#pragma unroll
                    for (int ib = 0; ib < 2; ++ib) {
                        const u32x4 u0 = uc[2 * ib], u1 = uc[2 * ib + 1];
                        vn[ib][0] = bflo(u0.x); vn[ib][1] = bfhi(u0.x); vn[ib][2] = bflo(u0.y); vn[ib][3] = bfhi(u0.y); vn[ib][4] = bflo(u0.z); vn[ib][5] = bfhi(u0.z); vn[ib][6] = bflo(u0.w); vn[ib][7] = bfhi(u0.w);
                        vn[ib][8] = bflo(u1.x); vn[ib][9] = bfhi(u1.x); vn[ib][10] = bflo(u1.y); vn[ib][11] = bfhi(u1.y); vn[ib][12] = bflo(u1.z); vn[ib][13] = bfhi(u1.z); vn[ib][14] = bflo(u1.w); vn[ib][15] = bfhi(u1.w);
#pragma unroll
                        for (int i = 0; i < 16; ++i) o[ib][i] = 0.f;
                    }
                    const float gl = glc;
                    if (c + 1 < 32) {
                        const unsigned char* upn = up0 + (size_t)(c + 1) * UUB;
#pragma unroll
                        for (int k = 0; k < 4; ++k) uc[k] = *(const GAS u32x4*)(upn + k * 1024);
                        glc = F.glast[ch0 + c + 1];
                    }
#pragma unroll
                    for (int ib = 0; ib < 2; ++ib)
#pragma unroll
                        for (int s = 0; s < 8; ++s) {
                            vn[ib] = __builtin_amdgcn_mfma_f32_32x32x16_bf16(GFRAG(ib * 8 + s), Sb[s >> 1][s & 1], vn[ib], 0, 0, 0);
                            o[ib] = __builtin_amdgcn_mfma_f32_32x32x16_bf16(GFRAG(16 + ib * 8 + s), Sb[s >> 1][s & 1], o[ib], 0, 0, 0);
                        }
                    bf16x8 Vb[2][2];
#pragma unroll
                    for (int ib = 0; ib < 2; ++ib) { Vb[ib][0] = pack8(vn[ib], 0); Vb[ib][1] = pack8(vn[ib], 1); }
                    o[0] = __builtin_amdgcn_mfma_f32_32x32x16_bf16(GFRAG(32), Vb[0][0], o[0], 0, 0, 0);
                    o[0] = __builtin_amdgcn_mfma_f32_32x32x16_bf16(GFRAG(33), Vb[0][1], o[0], 0, 0, 0);
#pragma unroll
                    for (int s = 0; s < 4; ++s) o[1] = __builtin_amdgcn_mfma_f32_32x32x16_bf16(GFRAG(34 + s), Vb[s >> 1][s & 1], o[1], 0, 0, 0);
#pragma unroll
                    for (int d = 0; d < 4; ++d) {
#pragma unroll
                        for (int i = 0; i < 16; ++i) S[d][i] *= gl;
#pragma unroll
                        for (int s = 0; s < 4; ++s) S[d] = __builtin_amdgcn_mfma_f32_32x32x16_bf16(GFRAG(38 + d * 4 + s), Vb[s >> 1][s & 1], S[d], 0, 0, 0);
                    }
#pragma unroll
                    for (int d = 0; d < 4; ++d) { Sb[d][0] = pack8(S[d], 0); Sb[d][1] = pack8(S[d], 1); }
#undef GFRAG
                    LAS unsigned short* st = (LAS unsigned short*)(L + STG + (c & 1) * STGB) + 32 * wave + n32;
#pragma unroll
                    for (int ib = 0; ib < 2; ++ib)
#pragma unroll
                        for (int r = 0; r < 16; ++r) st[(32 * ib + crow(r, hh)) * RS] = (unsigned short)f2bf(o[ib][r]);
                }
                LDS_WAIT();
                asm volatile("" ::: "memory"); __builtin_amdgcn_s_barrier(); asm volatile("" ::: "memory");
            }
            __builtin_amdgcn_s_setprio(0);
        }
    }
}


__device__ __forceinline__ void ln_rows_bf16(Frame& F, const bf16* y, float* out, const float* g, const float* b) {
    const int gw = F.vcu * NWAVES + F.wave, NGW = F.G * NWAVES, lane = F.lane;
    for (int m = gw; m < M; m += NGW) {
        const GAS v4u* yr = (const GAS v4u*)(y + (size_t)m * D) + lane;
        float v[4][8]; float s = 0.f;
#pragma unroll
        for (int j = 0; j < 4; ++j) { const v4u w = yr[64 * j];
            v[j][0] = bflo(w.x); v[j][1] = bfhi(w.x); v[j][2] = bflo(w.y); v[j][3] = bfhi(w.y); v[j][4] = bflo(w.z); v[j][5] = bfhi(w.z); v[j][6] = bflo(w.w); v[j][7] = bfhi(w.w);
#pragma unroll
            for (int e = 0; e < 8; ++e) s += v[j][e]; }
        const float mean = wave_sum(s) * (1.f / D); float s2 = 0.f;
#pragma unroll
        for (int j = 0; j < 4; ++j)
#pragma unroll
            for (int e = 0; e < 8; ++e) { v[j][e] -= mean; s2 += v[j][e] * v[j][e]; }
        const float rstd = rsqrtf(wave_sum(s2) * (1.f / D) + LN_EPS);
        GAS f32x4* orow = (GAS f32x4*)(out + (size_t)m * D);
#pragma unroll
        for (int j = 0; j < 4; ++j)
#pragma unroll
            for (int hf = 0; hf < 2; ++hf) { const int c4 = 128 * j + 2 * lane + hf;
                const f32x4 gv = *((const GAS f32x4*)g + c4), bv = *((const GAS f32x4*)b + c4);
                f32x4 o; o.x = v[j][4 * hf] * rstd * gv.x + bv.x; o.y = v[j][4 * hf + 1] * rstd * gv.y + bv.y; o.z = v[j][4 * hf + 2] * rstd * gv.z + bv.z; o.w = v[j][4 * hf + 3] * rstd * gv.w + bv.w;
                orow[c4] = o; }
    }
}

struct Args { const float* in[15]; float* out; unsigned char* ws; int ph_lo, ph_hi, li, pad; };
__global__ void __launch_bounds__(NWAVES * 64, 2) mk_fwd(Args args) {
    extern __shared__ __attribute__((aligned(16))) unsigned char lds[];
    Frame F;
    F.lds = (LAS unsigned char*)lds;
    F.MISC = (volatile LAS unsigned*)(F.lds + MISC_OFF);
    F.tid = threadIdx.x; F.lane = F.tid & 63; F.wave = __builtin_amdgcn_readfirstlane(F.tid >> 6);
    F.G = gridDim.x; { const int bx = blockIdx.x; F.vcu = (F.G % 8 == 0) ? (bx % 8) * (F.G / 8) + bx / 8 : bx; }
    unsigned char* ws = args.ws;
    F.ctl = (gu32*)(ws + WS_CTL);
    F.x = args.in[0]; F.w_in = args.in[1]; F.conv_w = args.in[2]; F.a_log = args.in[3]; F.dt_bias = args.in[4]; F.norm_w = args.in[5]; F.sinks = args.in[6]; F.rel_bias = args.in[7];
    F.w_o = args.in[8]; F.ln1_g = args.in[9]; F.ln1_b = args.in[10]; F.w_up = args.in[11]; F.w_down = args.in[12]; F.ln2_g = args.in[13]; F.ln2_b = args.in[14]; F.out = args.out;
    F.Win_t = (bf16*)(ws + WS_WIN); F.Wo_t = (bf16*)(ws + WS_WO); F.Wup_t = (bf16*)(ws + WS_WUP); F.Wdn_t = (bf16*)(ws + WS_WDN);
    F.xb = (bf16*)(ws + WS_XB); F.mix = (bf16*)(ws + WS_MIX); F.proj = (bf16*)(ws + WS_PROJ); F.x1b = (bf16*)(ws + WS_X1B); F.hb = (bf16*)(ws + WS_H);
    F.gbuf = (float*)(ws + WS_GB); F.gg = (float*)(ws + WS_GG); F.bb = (float*)(ws + WS_BB); F.biasd = (float*)(ws + WS_BIAS); F.biasT = (float*)(ws + WS_BIAS + 8192); F.glast = (float*)(ws + WS_BIAS + 16384);
    F.gz = (bf16*)(ws + WS_X1B + 32 * MiB);
    F.FR = (unsigned char*)args.out; F.UU = ws + WS_X1B;
    F.obuf = (float*)(ws + WS_OBUF);
    F.pc = (float*)(ws + WS_PC); F.pd = (float*)(ws + WS_PD); F.cv = (float*)(ws + WS_CV); F.dv = F.cv + FF; F.st32 = (float*)(ws + WS_ST32); F.rowstat = (float*)(ws + WS_RS);
    for (int u = F.tid; u < (LDS_BYTES - LDSCTL_OFF) / 4; u += NWAVES * 64) ((LAS unsigned*)(F.lds + LDSCTL_OFF))[u] = 0u;
    __syncthreads();
    XcdBarrier bar; bar.bar = (unsigned*)(F.ctl + CW_BAR); bar.x = 0; bar.st = nullptr;
    if (N_LAUNCHES != PER_PHASE) bar = xcd_barrier_post((unsigned*)(F.ctl + CW_BAR), F.MISC + 8);
#define GRID_BAR() do { if (N_LAUNCHES != PER_PHASE) xcd_barrier(bar); } while (0)
    const int lo = args.ph_lo, hi = args.ph_hi;
#define IN(k) (lo <= (k) && (k) < hi)
#define BOTH(k) (IN(k) && IN((k) + 1))

    if (IN(0)) { p0_prologue(F); if (BOTH(0)) GRID_BAR(); }
    if (IN(1)) {
        pg8::Gemm g{F.xb, F.Win_t, M, NPROJ, D}; pg8::StaticOrder S; S.init(M, NPROJ, F.G, (int)blockIdx.x);
        pg8::EpiProj E{F.proj, LDP, F.gbuf, QSCALE};
        pg8::gemm_phase<pg8::EpiProj, pg8::StaticOrder, true, true>(F.lds + RING_OFF, g, S, E);
        if (F.G == 256 && blockIdx.x >= 192) late_items(F, 0, LATE_SPLIT, ((int)blockIdx.x - 192) * NWAVES + F.wave, 64 * NWAVES);
        if (BOTH(1)) GRID_BAR();
    }
    if (IN(2)) { gdn_prep2(F); if (BOTH(2)) GRID_BAR(); }
    if (IN(3)) {
        if (F.G > 64) { if (blockIdx.x < 64) gdn_scan2(F, (int)blockIdx.x, 64); else { swa_mfma2(F, (int)blockIdx.x - 64, F.G - 64);
            if (F.G == 256) late_items(F, LATE_SPLIT, LATE_END, ((int)blockIdx.x - 64) * NWAVES + F.wave, 192 * NWAVES); } }
        else { gdn_scan2(F, (int)blockIdx.x, F.G); swa_mfma2(F, (int)blockIdx.x, F.G); }
        if (BOTH(3)) GRID_BAR();
    }
    if (IN(5)) {
        pg8::Gemm g{F.mix, F.Wo_t, M, D, D}; pg8::StaticOrder S; S.init(M, D, F.G, (int)blockIdx.x);
        pg8::EpiY1 E{F.xb, F.x1b, F.st32, D, DN_ALPHA, (LAS float*)(F.lds + 131072)};
        pg8::gemm_phase<pg8::EpiY1, pg8::StaticOrder, true, true>(F.lds + RING_OFF, g, S, E);
        for (int n0 = F.vcu * 32; n0 < FF; n0 += F.G * 32) {
            const int col = F.tid & 31, part = F.tid >> 5;
            float c = F.pc[(size_t)(2 * part) * FF + n0 + col] + F.pc[(size_t)(2 * part + 1) * FF + n0 + col];
            float d = F.pd[(size_t)(2 * part) * FF + n0 + col] + F.pd[(size_t)(2 * part + 1) * FF + n0 + col];
            LAS float* red = (LAS float*)(F.lds + 131072);
            red[part * 32 + col] = c; red[512 + part * 32 + col] = d;
            LDS_WAIT(); __syncthreads();
            if (F.tid < 64) { const LAS float* r = red + (F.tid >> 5) * 512 + (F.tid & 31); float s = 0.f;
#pragma unroll
                for (int p = 0; p < 16; ++p) s += r[p * 32];
                (F.tid < 32 ? F.cv : F.dv)[n0 + (F.tid & 31)] = s; }
            __syncthreads();
        }
        if (BOTH(5)) GRID_BAR();
    }
    if (IN(7)) {
        pg8::Gemm g{F.x1b, F.Wup_t, M, FF, D}; pg8::StaticOrder S; S.init(M, FF, F.G, (int)blockIdx.x);
        LAS float* tbl = (LAS float*)(F.lds + 131072 + 8192); pg8::Unit u0{0, 0}; (void)S.next(0, u0);
        if (F.tid < 256) { const f32x2 rs = pg8::rowstat8(F.st32, u0.pm * 256 + F.tid); tbl[2 * F.tid] = rs.x; tbl[2 * F.tid + 1] = rs.y; }
        LDS_WAIT(); __syncthreads();
        pg8::EpiUp E{F.hb, FF, F.st32, F.cv, F.dv, u0.pm};
        pg8::gemm_phase<pg8::EpiUp, pg8::StaticOrder, true, true>(F.lds + RING_OFF, g, S, E);
        if (BOTH(7)) GRID_BAR();
    }
    if (IN(8)) {
        pg8::Gemm g{F.hb, F.Wdn_t, M, D, FF}; pg8::StaticOrder S; S.init(M, D, F.G, (int)blockIdx.x);
        LAS float* tbl = (LAS float*)(F.lds + 131072 + 8192); pg8::Unit u0{0, 0}; (void)S.next(0, u0);
        if (F.tid < 256) { const f32x2 rs = pg8::rowstat8(F.st32, u0.pm * 256 + F.tid); tbl[2 * F.tid] = rs.x; tbl[2 * F.tid + 1] = rs.y; }
        LDS_WAIT(); __syncthreads();
        pg8::EpiDown E{F.x1b, D, F.st32, F.ln1_g, F.ln1_b, DN_ALPHA, u0.pm};
        pg8::gemm_phase<pg8::EpiDown, pg8::StaticOrder, true, true>(F.lds + RING_OFF, g, S, E);
        if (BOTH(8)) GRID_BAR();
    }
    if (IN(9)) { ln_rows_bf16(F, F.x1b, F.out, F.ln2_g, F.ln2_b); }
#undef IN
#undef BOTH
}

extern "C" void kernel_launch(void* const* d_in, const int* in_sizes, int n_in, void* d_out, int out_size, void* d_ws, size_t ws_size, hipStream_t stream) {
    static int grid = 0;
    if (grid == 0) {
        if (n_in != 15 || in_sizes[0] != M * D || out_size != M * D || ws_size < WS_END) { fprintf(stderr, "kernel_launch: unexpected shapes (n_in %d, in0 %d, out %d, ws %zu); nothing launched\n", n_in, n_in > 0 ? in_sizes[0] : -1, out_size, ws_size); grid = -1; return; }
        int dev = 0, cus = 0;
        if (hipGetDevice(&dev) != hipSuccess || hipDeviceGetAttribute(&cus, hipDeviceAttributeMultiprocessorCount, dev) != hipSuccess) { grid = -1; return; }
        if (hipFuncSetAttribute((const void*)mk_fwd, hipFuncAttributeMaxDynamicSharedMemorySize, LDS_BYTES) != hipSuccess) { fprintf(stderr, "kernel_launch: hipFuncSetAttribute failed\n"); grid = -1; return; }
        int per_cu = 0;
        if (hipOccupancyMaxActiveBlocksPerMultiprocessor(&per_cu, (const void*)mk_fwd, NWAVES * 64, LDS_BYTES) != hipSuccess || per_cu < 1)
            fprintf(stderr, "kernel_launch: note: occupancy query reports %d workgroups per CU\n", per_cu);
        (void)hipGetLastError();
        grid = cus;
    }
    if (grid < 0) return;
    if (hipMemsetAsync((char*)d_ws + WS_CTL, 0, CTL_ZERO_BYTES, stream) != hipSuccess) { fprintf(stderr, "kernel_launch: hipMemsetAsync failed\n"); return; }
    Args a{};
    for (int i = 0; i < 15; ++i) a.in[i] = (const float*)d_in[i];
    a.out = (float*)d_out; a.ws = (unsigned char*)d_ws;
    for (int li = 0; li < N_LAUNCHES; ++li) {
        a.ph_lo = (N_LAUNCHES == PER_PHASE) ? li : 0; a.ph_hi = (N_LAUNCHES == PER_PHASE) ? li + 1 : PER_PHASE; a.li = li;
        hipLaunchKernelGGL(mk_fwd, dim3(grid), dim3(NWAVES * 64), LDS_BYTES, stream, a);
        const hipError_t le = hipPeekAtLastError();
        if (le != hipSuccess) { fprintf(stderr, "kernel_launch: launch %d failed: %s\n", li, hipGetErrorName(le)); break; }
    }
}
```
